# Optimizing an MI355X kernel written in HIP

```python
import jax, jax.numpy as jnp
from jax import lax
import numpy as np

D_MODEL = 1024
BATCH = 2
SEQ = 8192
DEPTH = 1
DEC_BATCH = 128
DEC_SEQ = 4
PAST_LEN = 16384
PAGE_SIZE = 128

NH_M = 4
DHK_M = 128
DHV_M = 256
DQK_M = NH_M * DHK_M
DV_M = NH_M * DHV_M
CHUNK_M = 128
NH_A = 16
NKV_A = 4
HD_A = 64
WINDOW = 128
DQ_A = NH_A * HD_A
DKV_A = NKV_A * HD_A
D_FF = 2816
CONV_W = 3
N_MOD = 6
ALPHA = (2 * DEPTH) ** 0.25
BETA = (8 * DEPTH) ** -0.25
LN_EPS = 1e-5
IN_SPLITS = (DQK_M, DQK_M, DV_M, NH_M, NH_M, DV_M, DQ_A, DKV_A, DKV_A, D_MODEL, D_MODEL)
D_IN = DQK_M * 2 + DV_M * 2 + NH_M * 2 + DQ_A + DKV_A * 2 + D_MODEL * 2

kernel_name = 'hybrid_mlstm_swa_convffn_step'


def _ln(x, g=None, b=None):
    xf = x.astype(jnp.float32)
    mu = jnp.mean(xf, axis=-1, keepdims=True)
    var = jnp.mean(jnp.square(xf - mu), axis=-1, keepdims=True)
    y = (xf - mu) * lax.rsqrt(var + LN_EPS)
    if g is not None:
        y = y * g.astype(jnp.float32) + b.astype(jnp.float32)
    return y.astype(x.dtype)


def _split(z, sizes):
    out, off = [], 0
    for s in sizes:
        out.append(z[..., off:off + s])
        off += s
    return out


def _alibi_slopes():
    return jnp.exp2(-8.0 * jnp.arange(1, NH_A + 1, dtype=jnp.float32) / NH_A)


def _to_chunks(a, nc, t):
    b = a.shape[0]
    a = a.reshape((b, nc, t) + a.shape[2:])
    return jnp.transpose(a, (1, 0, 3, 2) + tuple(range(4, a.ndim)))


def _mlstm(q, k, v, ig, lf, C0, n0, m0):
    B, L = q.shape[:2]
    T = CHUNK_M if L % CHUNK_M == 0 else L
    NC = L // T
    f32 = jnp.float32
    qc = _to_chunks(q.astype(f32) * DHK_M ** -0.5, NC, T)
    kc = _to_chunks(k.astype(f32), NC, T)
    vc = _to_chunks(v.astype(f32), NC, T)
    ic = _to_chunks(ig, NC, T)
    fc = _to_chunks(lf, NC, T)
    causal = jnp.tril(jnp.ones((T, T), dtype=bool))

    def step(carry, inp):
        C, n, m = carry
        qx, kx, vx, ix, fx = inp
        b = jnp.cumsum(fx, axis=-1)
        dmat = b[..., :, None] - b[..., None, :] + ix[..., None, :]
        dmat = jnp.where(causal, dmat, -jnp.inf)
        inter = b + m[..., None]
        mt = jnp.maximum(inter, jnp.max(dmat, axis=-1))
        smat = jnp.einsum('bhtd,bhsd->bhts', qx, kx) * jnp.exp(dmat - mt[..., None])
        a_in = jnp.exp(inter - mt)
        num = jnp.einsum('bhts,bhsv->bhtv', smat, vx) + a_in[..., None] * jnp.einsum('bhvd,bhtd->bhtv', C, qx)
        den = jnp.sum(smat, axis=-1) + a_in * jnp.einsum('bhd,bhtd->bht', n, qx)
        h = num / jnp.maximum(jnp.abs(den), jnp.exp(-mt))[..., None]
        bT = b[..., -1]
        wk = bT[..., None] - b + ix
        m_new = jnp.maximum(bT + m, jnp.max(wk, axis=-1))
        decay = jnp.exp(bT + m - m_new)
        ws = jnp.exp(wk - m_new[..., None])
        C_new = decay[..., None, None] * C + jnp.einsum('bhs,bhsv,bhsd->bhvd', ws, vx, kx)
        n_new = decay[..., None] * n + jnp.einsum('bhs,bhsd->bhd', ws, kx)
        return (C_new, n_new, m_new), h

    (C, n, m), h = lax.scan(step, (C0.astype(f32), n0.astype(f32), m0.astype(f32)), (qc, kc, vc, ic, fc))
    h = jnp.transpose(h, (1, 0, 3, 2, 4)).reshape(B, L, NH_M, DHV_M)
    return h, C, n, m


def _swa(q, k, v, kbuf, vbuf, pos0, sinks):
    B, L = q.shape[:2]
    W = kbuf.shape[1]
    Qb = WINDOW if L % WINDOW == 0 else L
    NB = L // Qb
    G = NH_A // NKV_A
    f32 = jnp.float32
    kx = jnp.concatenate([kbuf.astype(k.dtype), k], axis=1)
    vx = jnp.concatenate([vbuf.astype(v.dtype), v], axis=1)
    idx = jnp.arange(NB)[:, None] * Qb + jnp.arange(W + Qb)[None, :]
    kb = kx[:, idx].astype(f32)
    vb = vx[:, idx].astype(f32)
    qb = q.reshape(B, NB, Qb, NKV_A, G, HD_A).astype(f32) * HD_A ** -0.5
    qpos = pos0 + jnp.arange(L).reshape(NB, Qb)
    kpos = pos0 - W + idx
    delta = qpos[:, :, None] - kpos[:, None, :]
    valid = (delta >= 0) & (delta < WINDOW) & (kpos[:, None, :] >= 0)
    slopes = _alibi_slopes().reshape(NKV_A, G)[:, :, None, None]
    s = jnp.einsum('bnqkgd,bnskd->bnkgqs', qb, kb)
    s = s - slopes * delta[:, None, None].astype(f32)
    s = jnp.where(valid[:, None, None], s, -jnp.inf)
    sink = sinks.astype(f32).reshape(NKV_A, G)[:, :, None, None]
    mx = jnp.maximum(jnp.max(s, axis=-1, keepdims=True), sink)
    p = jnp.exp(s - mx)
    den = jnp.sum(p, axis=-1, keepdims=True) + jnp.exp(sink - mx)
    o = jnp.einsum('bnkgqs,bnskd->bnqkgd', p / den, vb).reshape(B, L, NH_A * HD_A)
    return o, kx[:, -W:], vx[:, -W:]


def _conv_ffn(h, cbuf, w_up, b_up, conv_w, conv_b, w_down, b_down):
    L = h.shape[1]
    u = h @ w_up + b_up
    ux = jnp.concatenate([cbuf.astype(u.dtype), u], axis=1)
    y = conv_b + ux[:, 0:L] * conv_w[0]
    for j in range(1, CONV_W):
        y = y + ux[:, j:j + L] * conv_w[j]
    a, g = y[..., :D_FF], y[..., D_FF:]
    out = (jax.nn.gelu(a) * g) @ w_down + b_down
    return out, ux[:, L:]


def _layer(x, c, pos0, C0, n0, m0, kbuf, vbuf, cbuf,
           w_ada, b_ada, w_in, b_in, mlstm_norm_w, attn_sinks,
           w_branch_m, w_branch_a, w_out, ln1_g, ln1_b,
           w_up, b_up, conv_w, conv_b, w_down, b_down, ln2_g, ln2_b):
    B, L, _ = x.shape
    f32 = jnp.float32
    mod = (jax.nn.silu(c) @ w_ada + b_ada)[:, None, :]
    sh1, sc1, g1, sh2, sc2, g2 = jnp.split(mod, N_MOD, axis=-1)
    h = _ln(x) * (1.0 + sc1) + sh1
    z = h @ w_in + b_in
    qm, km, vm, ig, fg, og, qa, ka, va, gm, ga = _split(z, IN_SPLITS)
    hm, C, n, m = _mlstm(qm.reshape(B, L, NH_M, DHK_M), km.reshape(B, L, NH_M, DHK_M),
                         vm.reshape(B, L, NH_M, DHV_M), ig.astype(f32),
                         jax.nn.log_sigmoid(fg.astype(f32)), C0, n0, m0)
    hm = _ln(hm) * mlstm_norm_w.astype(f32).reshape(NH_M, DHV_M)
    hm = (hm.reshape(B, L, DV_M) * jax.nn.sigmoid(og.astype(f32))).astype(x.dtype)
    ha, k_new, v_new = _swa(qa.reshape(B, L, NH_A, HD_A), ka.reshape(B, L, NKV_A, HD_A),
                            va.reshape(B, L, NKV_A, HD_A), kbuf, vbuf, pos0, attn_sinks)
    merged = (jax.nn.sigmoid(gm) * (hm @ w_branch_m)
              + jax.nn.sigmoid(ga) * (ha.astype(x.dtype) @ w_branch_a))
    x = _ln(ALPHA * x + g1 * (merged @ w_out), ln1_g, ln1_b)
    h2 = _ln(x) * (1.0 + sc2) + sh2
    f, cbuf_new = _conv_ffn(h2, cbuf, w_up, b_up, conv_w, conv_b, w_down, b_down)
    x = _ln(ALPHA * x + g2 * f, ln2_g, ln2_b)
    dt = x.dtype
    return x, (C.astype(dt), n.astype(dt), m.astype(dt), k_new, v_new, cbuf_new)


def setup_inputs(seed: int = 0) -> dict:
    key = jax.random.key(seed)
    ks = iter(jax.random.split(key, 40))

    def nrm(shape, scale=1.0):
        return jax.random.normal(next(ks), shape, jnp.float32) * scale

    D = D_MODEL
    F2 = 2 * D_FF
    WB = min(WINDOW, PAST_LEN)
    f_off = 2 * DQK_M + DV_M + NH_M
    b_in = nrm((DEPTH, D_IN), 0.02).at[:, f_off:f_off + NH_M].add(3.0)
    return {
        'x_prompt': nrm((BATCH, SEQ, D)),
        'x_sample': nrm((DEC_BATCH, DEC_SEQ, D)),
        'c_prompt': nrm((BATCH, D)),
        'c_sample': nrm((DEC_BATCH, D)),
        'state_mlstm_C': nrm((DEPTH, DEC_BATCH, NH_M, DHV_M, DHK_M), 0.1),
        'state_mlstm_n': jnp.abs(nrm((DEPTH, DEC_BATCH, NH_M, DHK_M))),
        'state_mlstm_m': nrm((DEPTH, DEC_BATCH, NH_M)),
        'cache_k_win': nrm((DEPTH, DEC_BATCH, WB, NKV_A, HD_A)),
        'cache_v_win': nrm((DEPTH, DEC_BATCH, WB, NKV_A, HD_A)),
        'state_ffn_conv': nrm((DEPTH, DEC_BATCH, CONV_W - 1, F2), 0.5),
        'w_ada': nrm((DEPTH, D, N_MOD * D), D ** -0.5),
        'b_ada': nrm((DEPTH, N_MOD * D), 0.02),
        'w_in': nrm((DEPTH, D, D_IN), D ** -0.5),
        'b_in': b_in,
        'mlstm_norm_w': 1.0 + nrm((DEPTH, DV_M), 0.02),
        'attn_sinks': nrm((DEPTH, NH_A)),
        'w_branch_m': nrm((DEPTH, DV_M, D), BETA * DV_M ** -0.5),
        'w_branch_a': nrm((DEPTH, DQ_A, D), BETA * DQ_A ** -0.5),
        'w_out': nrm((DEPTH, D, D), BETA * D ** -0.5),
        'ln1_g': 1.0 + nrm((DEPTH, D), 0.02),
        'ln1_b': nrm((DEPTH, D), 0.02),
        'w_up': nrm((DEPTH, D, F2), D ** -0.5),
        'b_up': nrm((DEPTH, F2), 0.02),
        'conv_w': nrm((DEPTH, CONV_W, F2), CONV_W ** -0.5),
        'conv_b': nrm((DEPTH, F2), 0.02),
        'w_down': nrm((DEPTH, D_FF, D), BETA * D_FF ** -0.5),
        'b_down': nrm((DEPTH, D), 0.02),
        'ln2_g': 1.0 + nrm((DEPTH, D), 0.02),
        'ln2_b': nrm((DEPTH, D), 0.02),
    }


def reference(x_prompt, x_sample, c_prompt, c_sample, state_mlstm_C, state_mlstm_n, state_mlstm_m,
              cache_k_win, cache_v_win, state_ffn_conv, w_ada, b_ada, w_in, b_in, mlstm_norm_w,
              attn_sinks, w_branch_m, w_branch_a, w_out, ln1_g, ln1_b, w_up, b_up, conv_w, conv_b,
              w_down, b_down, ln2_g, ln2_b):
    params = (w_ada, b_ada, w_in, b_in, mlstm_norm_w, attn_sinks, w_branch_m, w_branch_a, w_out,
              ln1_g, ln1_b, w_up, b_up, conv_w, conv_b, w_down, b_down, ln2_g, ln2_b)
    Bp = x_prompt.shape[0]
    dt = x_prompt.dtype
    yp, ys = x_prompt, x_sample
    new_p, new_s = [], []
    for l in range(DEPTH):
        wl = [w[l] for w in params]
        yp, sp = _layer(yp, c_prompt, 0,
                        jnp.zeros((Bp, NH_M, DHV_M, DHK_M), dt), jnp.zeros((Bp, NH_M, DHK_M), dt),
                        jnp.zeros((Bp, NH_M), dt), jnp.zeros((Bp, WINDOW, NKV_A, HD_A), dt),
                        jnp.zeros((Bp, WINDOW, NKV_A, HD_A), dt), jnp.zeros((Bp, CONV_W - 1, 2 * D_FF), dt),
                        *wl)
        ys, ss = _layer(ys, c_sample, PAST_LEN, state_mlstm_C[l], state_mlstm_n[l], state_mlstm_m[l],
                        cache_k_win[l], cache_v_win[l], state_ffn_conv[l], *wl)
        new_p.append(sp)
        new_s.append(ss)
    p_C, p_n, p_m, p_k, p_v, p_conv = [jnp.stack(a) for a in zip(*new_p)]
    s_C, s_n, s_m, s_k, s_v, s_conv = [jnp.stack(a) for a in zip(*new_s)]
    return (yp, ys, p_C, p_n, p_m, p_k, p_v, p_conv, s_C, s_n, s_m, s_k, s_v, s_conv)
```

```cpp
#include <hip/hip_runtime.h>
#include <hip/hip_cooperative_groups.h>
#include <cstdio>
#include <cstdint>
namespace cg = cooperative_groups;

typedef unsigned short bf16_t;
typedef short bf16x8 __attribute__((ext_vector_type(8)));
typedef float f32x4 __attribute__((ext_vector_type(4)));
typedef float f32x2 __attribute__((ext_vector_type(2)));
typedef float f32x16 __attribute__((ext_vector_type(16)));
typedef unsigned u32x4 __attribute__((ext_vector_type(4)));
typedef unsigned u32x2 __attribute__((ext_vector_type(2)));
#define LAS __attribute__((address_space(3)))

constexpr int D = 1024, SEQ = 8192, MP = 16384, MS = 512, MT = 16896, NSEQ = 130;
constexpr int N1 = 6656, DIN = 6664, F2 = 5632, DFF = 2816;
constexpr float LN_EPS = 1e-5f;
constexpr float ALPHA = 1.189207115002721f;
constexpr size_t O_Y = 0, O_PC = 17301504, O_PN = 17563648, O_PM = 17564672, O_PK = 17564680, O_PV = 17630216, O_PCONV = 17695752,
                 O_SC = 17718280, O_SN = 34495496, O_SM = 34561032, O_SK = 34561544, O_SV = 38755848, O_SCONV = 42950152;
constexpr size_t MiB = 1u << 20;
constexpr size_t WS_W1T = 0;
constexpr size_t WS_UB = 0;
constexpr size_t WS_US = 4 * MiB;
constexpr size_t WS_WBR = 13 * MiB;
constexpr size_t WS_WOT = 17 * MiB;
constexpr size_t WS_WUT = 19 * MiB;
constexpr size_t WS_WDT = 30 * MiB;
constexpr size_t WS_MOD = 35 * MiB + 512 * 1024;
constexpr size_t WS_GATES = 38 * MiB + 640 * 1024;
constexpr size_t WS_MISC = 39 * MiB + 256 * 1024;
static_assert(WS_MOD + 130 * 6144 * 4 <= WS_GATES && WS_GATES + 16896 * 8 * 4 <= WS_MISC && WS_MISC + 81920 + 8 * 64 * 128 * 4 <= 40 * MiB, "ws map");
constexpr size_t MISC_WG = 0;
constexpr size_t MISC_BIASZ = 32768;
constexpr size_t MISC_CH = 65536;
constexpr size_t MISC_MC = 65536 + 4096;
constexpr size_t MISC_UN = 81920;
constexpr size_t WS_Z0 = 40 * MiB;
constexpr size_t WS_Z1 = 73 * MiB;
constexpr size_t WS_Z2 = 139 * MiB;
constexpr size_t WS_Z3 = 155 * MiB + 512 * 1024;
constexpr size_t WS_Z4 = 188 * MiB + 512 * 1024;
constexpr size_t WS_XP = 73 * MiB;
constexpr size_t WS_X1 = 200 * MiB;
constexpr size_t WS_ACT = 73 * MiB;
constexpr size_t WS_SCR = 164 * MiB;
constexpr size_t WS_BAR = 39 * MiB + 640 * 1024;
constexpr size_t WS_CNT = WS_BAR + 16384;
constexpr size_t WS_XBUF = 254 * MiB + 512 * 1024;
constexpr int LDS_BAR_OFF = 147456 - 256;
constexpr int LDS_BYTES = 147456;
#ifndef PH_MASK
#define PH_MASK 0x1FFF
#endif

__device__ __forceinline__ float bf2f(bf16_t b) { return __uint_as_float(((unsigned)b) << 16); }
typedef __bf16 bf16x2_t __attribute__((ext_vector_type(2)));
__device__ __forceinline__ unsigned pk2(float lo, float hi) { const f32x2 v = {lo, hi}; const bf16x2_t b = __builtin_convertvector(v, bf16x2_t); return __builtin_bit_cast(unsigned, b); }
__device__ __forceinline__ unsigned f2bf(float f) { return pk2(f, 0.f) & 0xffffu; }
__device__ __forceinline__ float lo16(unsigned w) { return __uint_as_float(w << 16); }
__device__ __forceinline__ float hi16(unsigned w) { return __uint_as_float(w & 0xffff0000u); }
__device__ __forceinline__ float sigmoidf_(float x) { return __builtin_amdgcn_rcpf(1.f + __expf(-x)); }
__device__ __forceinline__ float wave_sum(float v) {
#pragma unroll
    for (int o = 1; o < 64; o <<= 1) v += __shfl_xor(v, o);
    return v;
}
__device__ __forceinline__ float wave_max(float v) {
#pragma unroll
    for (int o = 1; o < 64; o <<= 1) v = fmaxf(v, __shfl_xor(v, o));
    return v;
}
__device__ __forceinline__ float gelu_tanh(float x) { const float y = 0.7978845608028654f * (x + 0.044715f * x * x * x); return x * sigmoidf_(2.f * y); }

namespace pg8 {
constexpr int BM = 256, BK = 64, HALF = 128, HTB = HALF * BK * 2, STAGE_BYTES = 8 * HTB, NXCD = 8, WGM = 8;
__host__ __device__ __forceinline__ int lds_byte(int r, int c) { const int st = (r >> 4) * 2 + (c >> 5), rr = r & 15, cc = c & 31, ob = rr * 64 + cc * 2; return st * 1024 + (ob ^ (((ob >> 9) & 1) << 5)); }
__host__ __device__ __forceinline__ void stage_rc(int b, int& R, int& C) { const int st = b / 1024, sb = b % 1024, swz = sb ^ (((sb >> 9) & 1) << 5); R = (st >> 1) * 16 + swz / 64; C = (st & 1) * 32 + (swz % 64) / 2; }
__host__ __device__ __forceinline__ int perm32(int rho) { const int n = rho >> 4, i = rho & 15; return 8 * (i >> 2) + 4 * n + (i & 3); }
struct Unit { int pm, pn; };
struct Gemm { const bf16_t* A; const bf16_t* Bt; int M, N, K, lda, ldb; };
struct StaticOrder {
    int nM, nN, nwg, G, c;
    __host__ __device__ __forceinline__ void init(int M, int N, int G_, int c_) { nM = M / BM; nN = N / BM; nwg = nM * nN; G = G_; c = c_; }
    __host__ __device__ __forceinline__ bool next(int i, Unit& u) const {
        const long L = (long)i * G + c; if (L >= nwg) return false;
        int wgid = (int)L; { const int q = nwg / NXCD, r = nwg % NXCD, xcd = wgid % NXCD, off = wgid / NXCD; wgid = (xcd < r ? xcd * (q + 1) : r * (q + 1) + (xcd - r) * q) + off; }
        const int nig = WGM * nN, gid = wgid / nig, fm = gid * WGM, gsz = (nM - fm) < WGM ? (nM - fm) : WGM;
        u.pm = fm + ((wgid % nig) % gsz); u.pn = (wgid % nig) / gsz; return true;
    }
};
template <class Epi>
__device__ __forceinline__ void gemm_phase(LAS unsigned char* lds, const Gemm g, const StaticOrder& S, const Epi& E) {
    int tid_ = threadIdx.x; asm volatile("" : "+v"(tid_));
    const int tid = tid_, wid = __builtin_amdgcn_readfirstlane(tid >> 6), lane = tid & 63, wr = wid >> 2, wc = wid & 3, fr = lane & 15, fq = lane >> 4;
    const int K = g.K, nt = K / BK;
    unsigned voffA[2], voffB[2];
#pragma unroll
    for (int i = 0; i < 2; ++i) { int R, C; stage_rc(tid * 16 + i * 8192, R, C); const int Rb = Epi::PERM ? ((R & ~31) + perm32(R & 31)) : R;
        voffA[i] = (unsigned)(R * g.lda + C) * 2u; voffB[i] = (unsigned)(Rb * g.ldb + C) * 2u; }
    const size_t kstep = (size_t)(BK * 2);
    const size_t hA = (size_t)HALF * g.lda * 2, hB = (size_t)HALF * g.ldb * 2;
    const size_t tA = 2 * hA, tB = 2 * hB;
    const unsigned ldsw = (unsigned)wid * 1024u;
    const int aoff = lds_byte(wr * 64 + fr, fq * 8), boff = lds_byte(wc * 32 + fr, fq * 8);
#define PG8_SA(b, h) (((b) * 2 + (h)) * HTB)
#define PG8_SB(b, h) ((4 + (b) * 2 + (h)) * HTB)
#define PG8_STAGE(bufoff, gbase, voff) do { _Pragma("unroll") for (int _i = 0; _i < 2; ++_i) \
        __builtin_amdgcn_global_load_lds((const unsigned*)((const char*)(gbase) + (voff)[_i]), (LAS unsigned*)(lds + (bufoff) + ldsw + _i * 8192), 16, 0, 0); } while (0)
#define PG8_LDA(dst, b, h) do { _Pragma("unroll") for (int m = 0; m < 4; ++m) _Pragma("unroll") for (int k = 0; k < 2; ++k) dst[m][k] = *(const LAS bf16x8*)(lds + PG8_SA(b, h) + aoff + m * 2048 + k * 1024); } while (0)
#define PG8_LDB(dst, b, h) do { _Pragma("unroll") for (int n = 0; n < 2; ++n) _Pragma("unroll") for (int k = 0; k < 2; ++k) dst[n][k] = *(const LAS bf16x8*)(lds + PG8_SB(b, h) + boff + n * 2048 + k * 1024); } while (0)
#define PG8_MMA(ai, bj, At, Bt) do { __builtin_amdgcn_s_setprio(1); _Pragma("unroll") for (int m = 0; m < 4; ++m) _Pragma("unroll") for (int n = 0; n < 2; ++n) _Pragma("unroll") for (int k = 0; k < 2; ++k) \
        acc[ai][bj][m][n] = __builtin_amdgcn_mfma_f32_16x16x32_bf16(Bt[n][k], At[m][k], acc[ai][bj][m][n], 0, 0, 0); __builtin_amdgcn_s_setprio(0); } while (0)
#define PG8_WAIT_V(n) asm volatile("s_waitcnt vmcnt(" #n ")" ::: "memory")
#define PG8_WAIT_L(n) asm volatile("s_waitcnt lgkmcnt(" #n ")" ::: "memory")
#define PG8_BAR __builtin_amdgcn_s_barrier()
#define PG8_SCHED __builtin_amdgcn_sched_barrier(0)
    Unit cur, nxt; int ui = 0;
    if (!S.next(0, cur)) return;
    f32x4 acc[2][2][4][2];
#pragma unroll
    for (int a = 0; a < 2; ++a)
#pragma unroll
        for (int b = 0; b < 2; ++b)
#pragma unroll
            for (int m = 0; m < 4; ++m)
#pragma unroll
                for (int n = 0; n < 2; ++n) acc[a][b][m][n] = (f32x4){0.f, 0.f, 0.f, 0.f};
    bf16x8 At[4][2], B0[2][2], B1[2][2];
    const char* cA = (const char*)g.A + (size_t)cur.pm * tA; const char* cB = (const char*)g.Bt + (size_t)cur.pn * tB;
    PG8_STAGE(PG8_SB(0, 0), cB, voffB); PG8_STAGE(PG8_SB(0, 1), cB + hB, voffB); PG8_STAGE(PG8_SA(0, 0), cA, voffA); PG8_STAGE(PG8_SA(0, 1), cA + hA, voffA);
    if (wr == 1) PG8_BAR;
    PG8_WAIT_V(2); PG8_BAR;
    PG8_STAGE(PG8_SB(1, 0), cB + kstep, voffB); PG8_STAGE(PG8_SA(1, 0), cA + kstep, voffA); PG8_STAGE(PG8_SB(1, 1), cB + hB + kstep, voffB);
    PG8_WAIT_V(6); PG8_BAR;
    for (;;) {
        const bool has_next = S.next(ui + 1, nxt);
        const char* nA = has_next ? (const char*)g.A + (size_t)nxt.pm * tA : cA; const char* nB = has_next ? (const char*)g.Bt + (size_t)nxt.pn * tB : cB;
        for (int t = 0; t < nt; t += 2) {
            const bool last = (t == nt - 2);
            const char* a1 = cA + (size_t)(t + 1) * kstep;
            const char* a2 = last ? nA : cA + (size_t)(t + 2) * kstep; const char* b2 = last ? nB : cB + (size_t)(t + 2) * kstep;
            const char* a3 = a2 + kstep; const char* b3 = b2 + kstep;
            if constexpr (Epi::HAS_MID) { if (t == nt / 2) E.mid(acc, cur, wr, wc, fr, fq); }
            PG8_LDB(B0, 0, 0); PG8_LDB(B1, 0, 1); PG8_SCHED; PG8_LDA(At, 0, 0); PG8_STAGE(PG8_SA(1, 1), a1 + hA, voffA);
            PG8_WAIT_V(8); PG8_WAIT_L(0); PG8_BAR; PG8_MMA(0, 0, At, B0); PG8_MMA(0, 1, At, B1); PG8_BAR; PG8_SCHED;
            PG8_LDA(At, 0, 1); PG8_STAGE(PG8_SB(0, 0), b2, voffB); PG8_STAGE(PG8_SB(0, 1), b2 + hB, voffB); PG8_STAGE(PG8_SA(0, 0), a2, voffA);
            PG8_WAIT_V(8); PG8_WAIT_L(0); PG8_BAR; PG8_MMA(1, 0, At, B0); PG8_MMA(1, 1, At, B1); PG8_BAR; PG8_SCHED;
            PG8_LDB(B0, 1, 0); PG8_LDB(B1, 1, 1); PG8_SCHED; PG8_LDA(At, 1, 0); PG8_STAGE(PG8_SA(0, 1), a2 + hA, voffA);
            PG8_WAIT_V(8); PG8_WAIT_L(0); PG8_BAR; PG8_MMA(0, 0, At, B0); PG8_MMA(0, 1, At, B1); PG8_BAR; PG8_SCHED;
            PG8_LDA(At, 1, 1); PG8_STAGE(PG8_SB(1, 0), b3, voffB); PG8_STAGE(PG8_SB(1, 1), b3 + hB, voffB); PG8_STAGE(PG8_SA(1, 0), a3, voffA);
            PG8_WAIT_V(8); PG8_WAIT_L(0); PG8_BAR; PG8_MMA(1, 0, At, B0); PG8_MMA(1, 1, At, B1); PG8_BAR; PG8_SCHED;
        }
        if (wr == 0) PG8_BAR;
        if constexpr (!Epi::AFTER_DRAIN) E(acc, cur, wr, wc, fr, fq);
        if (!has_next) break;
#pragma unroll
        for (int a = 0; a < 2; ++a)
#pragma unroll
            for (int b = 0; b < 2; ++b)
#pragma unroll
                for (int m = 0; m < 4; ++m)
#pragma unroll
                    for (int n = 0; n < 2; ++n) acc[a][b][m][n] = (f32x4){0.f, 0.f, 0.f, 0.f};
        cur = nxt; cA = nA; cB = nB; ++ui;
        if (wr == 1) PG8_BAR;
    }
    PG8_WAIT_V(0);
    PG8_BAR;
    if constexpr (Epi::AFTER_DRAIN) E.fused(acc, cur, lds);
#undef PG8_SA
#undef PG8_SB
#undef PG8_STAGE
#undef PG8_LDA
#undef PG8_LDB
#undef PG8_MMA
#undef PG8_WAIT_V
#undef PG8_WAIT_L
#undef PG8_BAR
#undef PG8_SCHED
}
}

typedef f32x4 Acc[2][2][4][2];

struct Params {
    const float *x_p, *x_s, *c_p, *c_s, *st_C, *st_n, *st_m, *ck, *cv, *st_conv;
    const float *w_ada, *b_ada, *w_in, *b_in, *mnorm, *sinks, *w_bm, *w_ba, *w_out, *ln1g, *ln1b, *w_up, *b_up, *conv_w, *conv_b, *w_down, *b_down, *ln2g, *ln2b;
    float* out; unsigned char* ws;
};

typedef const __attribute__((address_space(4))) Params* PP;
__device__ __forceinline__ int seq_of_row(int row) { return row < MP ? (row >> 13) : 2 + ((row - MP) >> 2); }

struct EpiZ {
    static constexpr bool PERM = true, HAS_MID = false, AFTER_DRAIN = false;
    unsigned char* ws; const float* biasz;
    __device__ __forceinline__ void operator()(const Acc& acc, const pg8::Unit& u, int wr, int wc, int fr, int fq) const {
        { int tv_ = threadIdx.x; asm volatile("" : "+v"(tv_)); fr = tv_ & 15; fq = (tv_ >> 4) & 3; wc = (tv_ >> 6) & 3; wr = tv_ >> 8; }
        const int pn = u.pn; size_t slab; int ldc, cb; float sc = 1.f;
        if (pn < 4) { slab = WS_Z0; ldc = 1024; cb = pn * 256; if (pn < 2) sc = 0.08838834764831845f; }
        else if (pn < 12) { slab = WS_Z1; ldc = 2048; cb = (pn - 4) * 256; if (pn >= 8) sc = 0.125f; }
        else if (pn < 14) { slab = WS_Z2; ldc = 512; cb = (pn - 12) * 256; }
        else if (pn < 18) { slab = WS_Z3; ldc = 1024; cb = (pn - 14) * 256; }
        else { slab = WS_Z4; ldc = 2048; cb = (pn - 18) * 256; }
        bf16_t* base = (bf16_t*)(ws + slab);
        const int row0 = u.pm * 256 + wr * 64 + fr, col0 = cb + wc * 32 + 8 * fq, bcol0 = pn * 256 + wc * 32 + 8 * fq;
        f32x4 bv[2][2];
#pragma unroll
        for (int bj = 0; bj < 2; ++bj)
#pragma unroll
            for (int n = 0; n < 2; ++n) bv[bj][n] = *(const f32x4*)(biasz + bcol0 + bj * 128 + 4 * n);
#pragma unroll
        for (int ai = 0; ai < 2; ++ai)
#pragma unroll
            for (int m = 0; m < 4; ++m) { bf16_t* rowp = base + (size_t)(row0 + ai * 128 + m * 16) * ldc + col0;
#pragma unroll
                for (int bj = 0; bj < 2; ++bj) { f32x4 v0 = (acc[ai][bj][m][0] + bv[bj][0]) * sc, v1 = (acc[ai][bj][m][1] + bv[bj][1]) * sc;
                    if (pn >= 14) { v0 = (f32x4){sigmoidf_(v0[0]), sigmoidf_(v0[1]), sigmoidf_(v0[2]), sigmoidf_(v0[3])}; v1 = (f32x4){sigmoidf_(v1[0]), sigmoidf_(v1[1]), sigmoidf_(v1[2]), sigmoidf_(v1[3])}; }
                    u32x4 w; w.x = pk2(v0[0], v0[1]); w.y = pk2(v0[2], v0[3]); w.z = pk2(v1[0], v1[1]); w.w = pk2(v1[2], v1[3]);
                    *(u32x4*)(rowp + bj * 128) = w; } }
    }
};

struct EpiBranch {
    static constexpr bool PERM = true, HAS_MID = true, AFTER_DRAIN = false;
    const bf16_t* Z4; bf16_t* O;
    __device__ __forceinline__ void mid(Acc& acc, const pg8::Unit& u, int wr, int wc, int fr, int fq) const {
        { int tv_ = threadIdx.x; asm volatile("" : "+v"(tv_)); fr = tv_ & 15; fq = (tv_ >> 4) & 3; wc = (tv_ >> 6) & 3; wr = tv_ >> 8; }
        const int row0 = u.pm * 256 + wr * 64 + fr, col0 = u.pn * 256 + wc * 32 + 8 * fq;
#pragma unroll
        for (int ai = 0; ai < 2; ++ai)
#pragma unroll
            for (int m = 0; m < 4; ++m) { const bf16_t* rp = Z4 + (size_t)(row0 + ai * 128 + m * 16) * 2048 + col0;
#pragma unroll
                for (int bj = 0; bj < 2; ++bj) { const u32x4 gm = *(const u32x4*)(rp + bj * 128), ga = *(const u32x4*)(rp + 1024 + bj * 128);
#pragma unroll
                    for (int q = 0; q < 4; ++q) { const float m0 = lo16(gm[q]), m1 = hi16(gm[q]), a0 = lo16(ga[q]), a1 = hi16(ga[q]);
                        const float r0 = m0 * __builtin_amdgcn_rcpf(a0), r1 = m1 * __builtin_amdgcn_rcpf(a1);
                        acc[ai][bj][m][q >> 1][(q & 1) * 2] *= r0; acc[ai][bj][m][q >> 1][(q & 1) * 2 + 1] *= r1; } } }
    }
    __device__ __forceinline__ void operator()(const Acc& acc, const pg8::Unit& u, int wr, int wc, int fr, int fq) const {
        { int tv_ = threadIdx.x; asm volatile("" : "+v"(tv_)); fr = tv_ & 15; fq = (tv_ >> 4) & 3; wc = (tv_ >> 6) & 3; wr = tv_ >> 8; }
        const int row0 = u.pm * 256 + wr * 64 + fr, col0 = u.pn * 256 + wc * 32 + 8 * fq;
#pragma unroll
        for (int ai = 0; ai < 2; ++ai)
#pragma unroll
            for (int m = 0; m < 4; ++m) { const size_t r = (size_t)(row0 + ai * 128 + m * 16);
#pragma unroll
                for (int bj = 0; bj < 2; ++bj) { const u32x4 ga = *(const u32x4*)(Z4 + r * 2048 + 1024 + col0 + bj * 128);
                    float v[8];
#pragma unroll
                    for (int q = 0; q < 4; ++q) { v[2 * q] = acc[ai][bj][m][q >> 1][(q & 1) * 2] * lo16(ga[q]); v[2 * q + 1] = acc[ai][bj][m][q >> 1][(q & 1) * 2 + 1] * hi16(ga[q]); }
                    u32x4 w; w.x = pk2(v[0], v[1]); w.y = pk2(v[2], v[3]); w.z = pk2(v[4], v[5]); w.w = pk2(v[6], v[7]);
                    *(u32x4*)(O + r * 1024 + col0 + bj * 128) = w; } }
    }
};

struct EpiRes {
    static constexpr bool PERM = false, HAS_MID = false, AFTER_DRAIN = false;
    const float *xp, *xs; const float* mod; int goff; bf16_t* obf;
    __device__ __forceinline__ void operator()(const Acc& acc, const pg8::Unit& u, int wr, int wc, int fr, int fq) const {
        { int tv_ = threadIdx.x; asm volatile("" : "+v"(tv_)); fr = tv_ & 15; fq = (tv_ >> 4) & 3; wc = (tv_ >> 6) & 3; wr = tv_ >> 8; }
        const int col0 = u.pn * 256 + wc * 32 + 4 * fq;
        const float* g = mod + (size_t)seq_of_row(u.pm * 256) * 6144 + goff;
        f32x4 gvv[2][2];
#pragma unroll
        for (int bj = 0; bj < 2; ++bj)
#pragma unroll
            for (int n = 0; n < 2; ++n) gvv[bj][n] = *(const f32x4*)(g + col0 + bj * 128 + n * 16);
#pragma unroll
        for (int ai = 0; ai < 2; ++ai)
#pragma unroll
            for (int m = 0; m < 4; ++m) { const int row = u.pm * 256 + ai * 128 + wr * 64 + m * 16 + fr;
                const float* bp = row < MP ? xp + (size_t)row * 1024 : xs + (size_t)(row - MP) * 1024;
#pragma unroll
                for (int bj = 0; bj < 2; ++bj)
#pragma unroll
                    for (int n = 0; n < 2; ++n) { const int c = col0 + bj * 128 + n * 16; const f32x4 gv = gvv[bj][n], xv = *(const f32x4*)(bp + c);
                        const f32x4 o = xv * ALPHA + gv * acc[ai][bj][m][n]; u32x2 w; w.x = pk2(o[0], o[1]); w.y = pk2(o[2], o[3]);
                        *(u32x2*)(obf + (size_t)row * 1024 + c) = w; } }
    }
};

struct EpiUp {
    static constexpr bool PERM = true, HAS_MID = false, AFTER_DRAIN = false;
    const float *b_up, *conv_w, *conv_b; bf16_t *scr, *UB, *US, *ACT; const float* st_conv; float* s_conv;
    __device__ __forceinline__ void operator()(const Acc& acc, const pg8::Unit& u, int wr, int wc, int fr, int fq) const {
        { int tv_ = threadIdx.x; asm volatile("" : "+v"(tv_)); fr = tv_ & 15; fq = (tv_ >> 4) & 3; wc = (tv_ >> 6) & 3; wr = tv_ >> 8; }
        const int pn = u.pn, pm = u.pm;
        const int cl0 = wc * 32 + 8 * fq;
        f32x4 bv[2][2];
#pragma unroll
        for (int bj = 0; bj < 2; ++bj)
#pragma unroll
            for (int n = 0; n < 2; ++n) bv[bj][n] = *(const f32x4*)(b_up + bj * DFF + pn * 128 + cl0 + 4 * n);
#pragma unroll
        for (int ai = 0; ai < 2; ++ai)
#pragma unroll
            for (int m = 0; m < 4; ++m) { const int rt = ai * 128 + wr * 64 + m * 16 + fr;
#pragma unroll
                for (int bj = 0; bj < 2; ++bj) { const f32x4 v0 = acc[ai][bj][m][0] + bv[bj][0], v1 = acc[ai][bj][m][1] + bv[bj][1];
                    u32x4 w; w.x = pk2(v0[0], v0[1]); w.y = pk2(v0[2], v0[3]); w.z = pk2(v1[0], v1[1]); w.w = pk2(v1[2], v1[3]);
                    *(u32x4*)(scr + rt * 256 + bj * 128 + cl0) = w; }
                __builtin_amdgcn_sched_barrier(0); }
        asm volatile("s_waitcnt vmcnt(0)" ::: "memory"); __builtin_amdgcn_s_barrier(); asm volatile("" ::: "memory");
        const int tid = threadIdx.x;
#define SCR_LD(p) __hip_atomic_load((const unsigned*)(p), __ATOMIC_RELAXED, __HIP_MEMORY_SCOPE_AGENT)
        if (pm >= 64) {
            const int f0 = (tid & 63) * 2, ca = pn * 128 + f0;
            const f32x2 cba = *(const f32x2*)(conv_b + ca), cbg = *(const f32x2*)(conv_b + DFF + ca);
            const f32x2 wa0 = *(const f32x2*)(conv_w + ca), wa1 = *(const f32x2*)(conv_w + F2 + ca), wa2 = *(const f32x2*)(conv_w + 2 * F2 + ca);
            const f32x2 wg0 = *(const f32x2*)(conv_w + DFF + ca), wg1 = *(const f32x2*)(conv_w + F2 + DFF + ca), wg2 = *(const f32x2*)(conv_w + 2 * F2 + DFF + ca);
#pragma unroll 1
            for (int hb = 0; hb < 2; ++hb) { const int r0 = (tid >> 6) * 32 + 16 * hb;
                unsigned ua[16], ug[16];
#pragma unroll
                for (int i = 0; i < 16; ++i) { ua[i] = SCR_LD(scr + (r0 + i) * 256 + f0); ug[i] = SCR_LD(scr + (r0 + i) * 256 + 128 + f0); }
#pragma unroll
                for (int sq4 = 0; sq4 < 4; ++sq4) { const int srow0 = (pm - 64) * 256 + r0 + 4 * sq4, bq = srow0 >> 2;
                    const f32x2 c0a = *(const f32x2*)(st_conv + ((size_t)bq * 2 + 0) * F2 + ca), c1a = *(const f32x2*)(st_conv + ((size_t)bq * 2 + 1) * F2 + ca);
                    const f32x2 c0g = *(const f32x2*)(st_conv + ((size_t)bq * 2 + 0) * F2 + DFF + ca), c1g = *(const f32x2*)(st_conv + ((size_t)bq * 2 + 1) * F2 + DFF + ca);
#pragma unroll
                    for (int t = 0; t < 4; ++t) { const int it = 4 * sq4 + t;
                        const f32x2 xa2 = (f32x2){lo16(ua[it]), hi16(ua[it])}, xg2 = (f32x2){lo16(ug[it]), hi16(ug[it])};
                        const f32x2 xa1 = t >= 1 ? (f32x2){lo16(ua[it - (t >= 1 ? 1 : 0)]), hi16(ua[it - (t >= 1 ? 1 : 0)])} : c1a, xg1 = t >= 1 ? (f32x2){lo16(ug[it - (t >= 1 ? 1 : 0)]), hi16(ug[it - (t >= 1 ? 1 : 0)])} : c1g;
                        const f32x2 xa0 = t >= 2 ? (f32x2){lo16(ua[it - (t >= 2 ? 2 : 0)]), hi16(ua[it - (t >= 2 ? 2 : 0)])} : (t == 0 ? c0a : c1a), xg0 = t >= 2 ? (f32x2){lo16(ug[it - (t >= 2 ? 2 : 0)]), hi16(ug[it - (t >= 2 ? 2 : 0)])} : (t == 0 ? c0g : c1g);
                        const float av0 = cba[0] + wa0[0] * xa0[0] + wa1[0] * xa1[0] + wa2[0] * xa2[0], av1 = cba[1] + wa0[1] * xa0[1] + wa1[1] * xa1[1] + wa2[1] * xa2[1];
                        const float gv0 = cbg[0] + wg0[0] * xg0[0] + wg1[0] * xg1[0] + wg2[0] * xg2[0], gv1 = cbg[1] + wg0[1] * xg0[1] + wg1[1] * xg1[1] + wg2[1] * xg2[1];
                        *(unsigned*)(ACT + (size_t)(MP + srow0 + t) * DFF + ca) = pk2(gelu_tanh(av0) * gv0, gelu_tanh(av1) * gv1);
                        if (t >= 2) { *(f32x2*)(s_conv + ((size_t)bq * 2 + (t - 2)) * F2 + ca) = xa2; *(f32x2*)(s_conv + ((size_t)bq * 2 + (t - 2)) * F2 + DFF + ca) = xg2; } } } }
        } else
        {
            const int f0 = (tid & 63) * 2, ca = pn * 128 + f0;
            const f32x2 cba = *(const f32x2*)(conv_b + ca), cbg = *(const f32x2*)(conv_b + DFF + ca);
            const f32x2 wa0 = *(const f32x2*)(conv_w + ca), wa1 = *(const f32x2*)(conv_w + F2 + ca), wa2 = *(const f32x2*)(conv_w + 2 * F2 + ca);
            const f32x2 wg0 = *(const f32x2*)(conv_w + DFF + ca), wg1 = *(const f32x2*)(conv_w + F2 + DFF + ca), wg2 = *(const f32x2*)(conv_w + 2 * F2 + DFF + ca);
#pragma unroll 1
            for (int hb = 0; hb < 2; ++hb) { const int r0 = (tid >> 6) * 32 + 16 * hb;
            unsigned ua[18], ug[18];
#pragma unroll
            for (int i = 0; i < 18; ++i) { int r = r0 - 2 + i; r = r < 0 ? 0 : r; ua[i] = SCR_LD(scr + r * 256 + f0); ug[i] = SCR_LD(scr + r * 256 + 128 + f0); }
#pragma unroll
            for (int it = 0; it < 16; ++it) { const int rt = r0 + it; const unsigned a0 = ua[it], a1 = ua[it + 1], a2 = ua[it + 2], g0 = ug[it], g1 = ug[it + 1], g2 = ug[it + 2];
                if (rt < 2) { *(unsigned*)(UB + ((size_t)pm * 4 + 2 + rt) * F2 + ca) = a2; *(unsigned*)(UB + ((size_t)pm * 4 + 2 + rt) * F2 + DFF + ca) = g2; continue; }
                if (rt >= 254) { *(unsigned*)(UB + ((size_t)(pm + 1) * 4 + (rt - 254)) * F2 + ca) = a2; *(unsigned*)(UB + ((size_t)(pm + 1) * 4 + (rt - 254)) * F2 + DFF + ca) = g2; }
                const float av0 = cba[0] + wa0[0] * lo16(a0) + wa1[0] * lo16(a1) + wa2[0] * lo16(a2), av1 = cba[1] + wa0[1] * hi16(a0) + wa1[1] * hi16(a1) + wa2[1] * hi16(a2);
                const float gv0 = cbg[0] + wg0[0] * lo16(g0) + wg1[0] * lo16(g1) + wg2[0] * lo16(g2), gv1 = cbg[1] + wg0[1] * hi16(g0) + wg1[1] * hi16(g1) + wg2[1] * hi16(g2);
                *(unsigned*)(ACT + (size_t)(pm * 256 + rt) * DFF + ca) = pk2(gelu_tanh(av0) * gv0, gelu_tanh(av1) * gv1); }
            }
        }
#undef SCR_LD
        asm volatile("s_waitcnt vmcnt(0)" ::: "memory"); __builtin_amdgcn_s_barrier();
    }
};


struct EpiDownLn {
    static constexpr bool PERM = false, HAS_MID = false, AFTER_DRAIN = true;
    const float* mod; const float *bias, *gam, *bet; float* out; const bf16_t* x1; unsigned long long* xbuf; unsigned* cnt;
    __device__ __forceinline__ void fused(Acc& acc, const pg8::Unit& u, LAS unsigned char* lds) const {
        int tv_ = threadIdx.x; asm volatile("" : "+v"(tv_));
        const int lane = tv_ & 63, wid = __builtin_amdgcn_readfirstlane(tv_ >> 6), fr = lane & 15, fq = lane >> 4, wc = wid & 3, wr = wid >> 2;
        LAS f32x2* Pp = (LAS f32x2*)lds;
        LAS f32x2* S = (LAS f32x2*)(lds + 8192);
        const int col0 = u.pn * 256 + wc * 32 + 4 * fq;
        const float* g = mod + (size_t)(u.pm >> 5) * 6144 + 5120;
#pragma unroll
        for (int bj = 0; bj < 2; ++bj)
#pragma unroll
            for (int n = 0; n < 2; ++n) { const int c = col0 + bj * 128 + n * 16; const f32x4 gv = *(const f32x4*)(g + c), bv = *(const f32x4*)(bias + c);
#pragma unroll
                for (int ai = 0; ai < 2; ++ai)
#pragma unroll
                    for (int m = 0; m < 4; ++m) acc[ai][bj][m][n] = gv * (acc[ai][bj][m][n] + bv); }
#pragma unroll
        for (int ai = 0; ai < 2; ++ai)
#pragma unroll
            for (int m = 0; m < 4; ++m) { const bf16_t* xr = x1 + (size_t)(u.pm * 256 + ai * 128 + wr * 64 + m * 16 + fr) * 1024 + col0;
#pragma unroll
                for (int bj = 0; bj < 2; ++bj)
#pragma unroll
                    for (int n = 0; n < 2; ++n) { const u32x2 xw = *(const u32x2*)(xr + bj * 128 + n * 16); acc[ai][bj][m][n] = acc[ai][bj][m][n] + (f32x4){lo16(xw.x), hi16(xw.x), lo16(xw.y), hi16(xw.y)} * ALPHA; }
                asm volatile("" : "+v"(acc[ai][0][m][0]), "+v"(acc[ai][0][m][1]), "+v"(acc[ai][1][m][0]), "+v"(acc[ai][1][m][1]));
                if (m & 1) asm volatile("" ::: "memory"); }
#pragma unroll
        for (int ai = 0; ai < 2; ++ai)
#pragma unroll
            for (int m = 0; m < 4; ++m) { float s = 0.f;
#pragma unroll
                for (int bj = 0; bj < 2; ++bj)
#pragma unroll
                    for (int n = 0; n < 2; ++n) { const f32x4 x = acc[ai][bj][m][n]; s += (x[0] + x[1]) + (x[2] + x[3]); }
                s += __shfl_xor(s, 16); s += __shfl_xor(s, 32);
                const float mw = s * (1.0f / 64.0f); float q = 0.f;
#pragma unroll
                for (int bj = 0; bj < 2; ++bj)
#pragma unroll
                    for (int n = 0; n < 2; ++n) { const f32x4 d = acc[ai][bj][m][n] - mw; q += (d[0] * d[0] + d[1] * d[1]) + (d[2] * d[2] + d[3] * d[3]); }
                q += __shfl_xor(q, 16); q += __shfl_xor(q, 32);
                if (fq == 0) Pp[(ai * 128 + wr * 64 + m * 16 + fr) * 4 + wc] = (f32x2){mw, q}; }
        asm volatile("s_waitcnt lgkmcnt(0)" ::: "memory"); __builtin_amdgcn_s_barrier(); asm volatile("" ::: "memory");
        const int row = wid * 32 + (lane & 31);
        if (lane < 32) { const f32x2 a = Pp[row * 4 + 0], b = Pp[row * 4 + 1], cc = Pp[row * 4 + 2], d = Pp[row * 4 + 3];
            const float mt = (a.x + b.x + cc.x + d.x) * 0.25f; const float da = a.x - mt, db = b.x - mt, dc = cc.x - mt, dd = d.x - mt;
            const float m2 = (a.y + b.y) + (cc.y + d.y) + 64.0f * ((da * da + db * db) + (dc * dc + dd * dd));
            __hip_atomic_store(xbuf + ((size_t)(u.pm * 256 + row) * 4 + u.pn), ((unsigned long long)__float_as_uint(m2) << 32) | __float_as_uint(mt), __ATOMIC_RELAXED, __HIP_MEMORY_SCOPE_AGENT); }
        asm volatile("s_waitcnt vmcnt(0)" ::: "memory");
        if (lane == 0) __hip_atomic_fetch_add(cnt + 64 * u.pm, 1u, __ATOMIC_RELAXED, __HIP_MEMORY_SCOPE_AGENT);
        if (wid == 0) { unsigned sp = 0;
            while ((unsigned)__builtin_amdgcn_readfirstlane(__hip_atomic_load(cnt + 64 * u.pm, __ATOMIC_RELAXED, __HIP_MEMORY_SCOPE_AGENT)) < 32u) { __builtin_amdgcn_s_sleep(2); if (++sp > (1u << 24)) break; }
            __builtin_amdgcn_fence(__ATOMIC_ACQUIRE, "agent"); }
        asm volatile("s_waitcnt vmcnt(0) lgkmcnt(0)" ::: "memory"); __builtin_amdgcn_s_barrier(); asm volatile("" ::: "memory");
        if (lane < 32) { const unsigned long long* slot = xbuf + (size_t)(u.pm * 256 + row) * 4; float mt[4], m2[4]; float ms = 0.f;
#pragma unroll
            for (int t = 0; t < 4; ++t) { const unsigned long long w = __hip_atomic_load(slot + t, __ATOMIC_RELAXED, __HIP_MEMORY_SCOPE_AGENT); mt[t] = __uint_as_float((unsigned)w); m2[t] = __uint_as_float((unsigned)(w >> 32)); ms += mt[t]; }
            const float mean = ms * 0.25f; float q = 0.f;
#pragma unroll
            for (int t = 0; t < 4; ++t) { const float dm = mt[t] - mean; q += m2[t] + 256.0f * dm * dm; }
            S[row] = (f32x2){mean, 1.0f / sqrtf(q * (1.0f / 1024.0f) + LN_EPS)}; }
        asm volatile("s_waitcnt lgkmcnt(0)" ::: "memory"); __builtin_amdgcn_s_barrier(); asm volatile("" ::: "memory");
#pragma unroll
        for (int bj = 0; bj < 2; ++bj)
#pragma unroll
            for (int n = 0; n < 2; ++n) { const int c = col0 + bj * 128 + n * 16; const f32x4 gm = *(const f32x4*)(gam + c), bt = *(const f32x4*)(bet + c);
#pragma unroll
                for (int ai = 0; ai < 2; ++ai)
#pragma unroll
                    for (int m = 0; m < 4; ++m) { const int r = ai * 128 + wr * 64 + m * 16 + fr; const f32x2 sr = S[r];
                        *(f32x4*)(out + (size_t)(u.pm * 256 + r) * 1024 + c) = (acc[ai][bj][m][n] - sr.x) * sr.y * gm + bt; } }
    }
    __device__ __forceinline__ void operator()(const Acc&, const pg8::Unit&, int, int, int, int) const {}
};

struct Ctx { int tid, lane, wave, vw, nvw; };

__device__ __forceinline__ void transpose_item(const float* W, int ldw, int k0, int csrc, bf16_t* dst, int ldd, int drow, int dcol, float* scr, int lane) {
    float tv_[32];
#pragma unroll
    for (int i = 0; i < 32; ++i) tv_[i] = W[(size_t)(k0 + 2 * i + (lane >> 5)) * ldw + csrc + (lane & 31)];
#pragma unroll
    for (int i = 0; i < 32; ++i) scr[(2 * i + (lane >> 5)) * 33 + (lane & 31)] = tv_[i];
    __builtin_amdgcn_fence(__ATOMIC_RELEASE, "wavefront"); asm volatile("s_waitcnt lgkmcnt(0)" ::: "memory");
    const int c = lane & 7;
#pragma unroll
    for (int j = 0; j < 4; ++j) { const int n = (lane >> 3) + 8 * j; const float* s = scr + (8 * c) * 33 + n;
        u32x4 o; o.x = pk2(s[0 * 33], s[1 * 33]); o.y = pk2(s[2 * 33], s[3 * 33]); o.z = pk2(s[4 * 33], s[5 * 33]); o.w = pk2(s[6 * 33], s[7 * 33]);
        *(u32x4*)(dst + (size_t)(drow + n) * ldd + dcol + k0 + 8 * c) = o; }
    asm volatile("s_waitcnt lgkmcnt(0)" ::: "memory");
}
__device__ __forceinline__ int srcmap(int c) { return c < 2048 ? c : (c < 3584 ? c + 1032 : (c < 4608 ? c - 1528 : c + 8)); }

__device__ __forceinline__ void ada_task(PP P, int task, int lane) {
    const int n0 = (task / 3) * 16, rt0 = (task % 3) * 3, fr = lane & 15, kg = lane >> 4;
    f32x4 acc[3];
#pragma unroll
    for (int r = 0; r < 3; ++r) acc[r] = (f32x4){0.f, 0.f, 0.f, 0.f};
    const float* crow[3];
#pragma unroll
    for (int r = 0; r < 3; ++r) { int s = 16 * (rt0 + r) + fr; if (s > NSEQ - 1) s = NSEQ - 1; crow[r] = s < 2 ? P->c_p + (size_t)s * D : P->c_s + (size_t)(s - 2) * D; }
#pragma unroll 4
    for (int ks = 0; ks < 32; ++ks) { const int k0 = ks * 32 + 8 * kg;
        float wv[8];
#pragma unroll
        for (int j = 0; j < 8; ++j) wv[j] = P->w_ada[(size_t)(k0 + j) * 6144 + n0 + fr];
        bf16x8 b;
#pragma unroll
        for (int j = 0; j < 8; ++j) b[j] = (short)f2bf(wv[j]);
#pragma unroll
        for (int r = 0; r < 3; ++r) { const f32x4 c0 = *(const f32x4*)(crow[r] + k0), c1 = *(const f32x4*)(crow[r] + k0 + 4);
            bf16x8 a;
#pragma unroll
            for (int j = 0; j < 4; ++j) { a[j] = (short)f2bf(c0[j] * sigmoidf_(c0[j])); a[4 + j] = (short)f2bf(c1[j] * sigmoidf_(c1[j])); }
            acc[r] = __builtin_amdgcn_mfma_f32_16x16x32_bf16(a, b, acc[r], 0, 0, 0); } }
    float* mod = (float*)(P->ws + WS_MOD); const float bb = P->b_ada[n0 + fr];
#pragma unroll
    for (int r = 0; r < 3; ++r)
#pragma unroll
        for (int j = 0; j < 4; ++j) { const int s = 16 * (rt0 + r) + 4 * kg + j; if (s < NSEQ) mod[(size_t)s * 6144 + n0 + fr] = acc[r][j] + bb; }
}

constexpr int APITCH = 1032;
__device__ __forceinline__ void ada_block_task(PP P, unsigned char* lds, const Ctx& c, int task) {
    const int rg = task % 3, cg = task / 3, fr = c.lane & 15, kg = c.lane >> 4;
    bf16_t* As = (bf16_t*)lds;
#pragma unroll 12
    for (int i = 0; i < 24; ++i) { const int id = c.tid + 512 * i, r = id >> 8, k4 = id & 255; int s = 48 * rg + r; s = s > NSEQ - 1 ? NSEQ - 1 : s;
        const float* src = s < 2 ? P->c_p + (size_t)s * D : P->c_s + (size_t)(s - 2) * D; const f32x4 v = *(const f32x4*)(src + 4 * k4);
        u32x2 w; w.x = pk2(v[0] * sigmoidf_(v[0]), v[1] * sigmoidf_(v[1])); w.y = pk2(v[2] * sigmoidf_(v[2]), v[3] * sigmoidf_(v[3]));
        *(u32x2*)(As + r * APITCH + 4 * k4) = w; }
    __syncthreads();
    const int n0 = 128 * cg + 16 * c.wave;
    f32x4 acc[3];
#pragma unroll
    for (int r = 0; r < 3; ++r) acc[r] = (f32x4){0.f, 0.f, 0.f, 0.f};
#pragma unroll 16
    for (int ks = 0; ks < 32; ++ks) { const int k0 = ks * 32 + 8 * kg;
        float wv[8];
#pragma unroll
        for (int j = 0; j < 8; ++j) wv[j] = P->w_ada[(size_t)(k0 + j) * 6144 + n0 + fr];
        u32x4 bw; bw.x = pk2(wv[0], wv[1]); bw.y = pk2(wv[2], wv[3]); bw.z = pk2(wv[4], wv[5]); bw.w = pk2(wv[6], wv[7]);
        const bf16x8 b = __builtin_bit_cast(bf16x8, bw);
#pragma unroll
        for (int r = 0; r < 3; ++r) { const bf16x8 a = *(const bf16x8*)(As + (16 * r + fr) * APITCH + k0); acc[r] = __builtin_amdgcn_mfma_f32_16x16x32_bf16(a, b, acc[r], 0, 0, 0); } }
    float* mod = (float*)(P->ws + WS_MOD); const float bb = P->b_ada[n0 + fr];
#pragma unroll
    for (int r = 0; r < 3; ++r)
#pragma unroll
        for (int j = 0; j < 4; ++j) { const int s = 48 * rg + 16 * r + 4 * kg + j; if (s < NSEQ) mod[(size_t)s * 6144 + n0 + fr] = acc[r][j] + bb; }
    __syncthreads();
}

__device__ __forceinline__ void phase0(PP P, unsigned char* lds, const Ctx& c) {
    float* scr = (float*)(lds + c.wave * 16384);
    { float* wg = (float*)(P->ws + WS_MISC + MISC_WG); float* bz = (float*)(P->ws + WS_MISC + MISC_BIASZ);
      for (int i = blockIdx.x * 512 + c.tid; i < 8192; i += gridDim.x * 512) { const int g = i >> 10, k = i & 1023; wg[i] = P->w_in[(size_t)k * DIN + 2048 + g]; }
      for (int i = blockIdx.x * 512 + c.tid; i < N1; i += gridDim.x * 512) bz[i] = P->b_in[srcmap(i)]; }
    constexpr int T_ADA = 144, I_IN = 16 * 208;
    const int G = gridDim.x, bid = blockIdx.x;
    if (G > T_ADA) {
        if (bid < T_ADA) { ada_block_task(P, lds, c, bid); return; }
        const int tv = (bid - T_ADA) * 8 + c.wave, tn = (G - T_ADA) * 8;
        for (int r = tv; r < I_IN; r += tn) { const int kb = r / 208, nb = r % 208; transpose_item(P->w_in, DIN, 64 * kb, srcmap(32 * nb), (bf16_t*)(P->ws + WS_W1T), 1024, 32 * nb, 0, scr, c.lane); }
    } else {
        for (int t = bid; t < T_ADA; t += G) ada_block_task(P, lds, c, t);
        for (int r = bid * 8 + c.wave; r < I_IN; r += G * 8) { const int kb = r / 208, nb = r % 208; transpose_item(P->w_in, DIN, 64 * kb, srcmap(32 * nb), (bf16_t*)(P->ws + WS_W1T), 1024, 32 * nb, 0, scr, c.lane); }
    }
}

__device__ __forceinline__ void late_copies_a(PP P, unsigned char* lds, const Ctx& c, int rank, int nrk) {
    float* scr = (float*)(lds + c.wave * 16384); constexpr int I_B = 512, I_UP = 16 * 176;
    for (int r = rank; r < I_B; r += nrk) { const int kb = r / 32, nb = r % 32; transpose_item(P->w_bm, 1024, 64 * kb, 32 * nb, (bf16_t*)(P->ws + WS_WBR), 2048, 32 * nb, 0, scr, c.lane); }
    for (int r = rank; r < I_B; r += nrk) { const int kb = r / 32, nb = r % 32; transpose_item(P->w_ba, 1024, 64 * kb, 32 * nb, (bf16_t*)(P->ws + WS_WBR), 2048, 32 * nb, 1024, scr, c.lane); }
    for (int r = rank; r < I_B; r += nrk) { const int kb = r / 32, nb = r % 32; transpose_item(P->w_out, 1024, 64 * kb, 32 * nb, (bf16_t*)(P->ws + WS_WOT), 1024, 32 * nb, 0, scr, c.lane); }
    for (int r = rank; r < I_UP; r += nrk) { const int kb = r / 176, nb = r % 176; const int cs = 32 * nb; const int j = cs < DFF ? cs : cs - DFF; const int drow = 256 * (j >> 7) + (cs < DFF ? 0 : 128) + (j & 127);
        transpose_item(P->w_up, F2, 64 * kb, cs, (bf16_t*)(P->ws + WS_WUT), 1024, drow, 0, scr, c.lane); }
}
__device__ __forceinline__ void late_copies_b(PP P, unsigned char* lds, const Ctx& c, int rank, int nrk) {
    float* scr = (float*)(lds + c.wave * 16384); constexpr int I_DN = 44 * 32;
    for (int r = rank; r < I_DN; r += nrk) { const int kb = r / 32, nb = r % 32; transpose_item(P->w_down, 1024, 64 * kb, 32 * nb, (bf16_t*)(P->ws + WS_WDT), DFF, 32 * nb, 0, scr, c.lane); }
}

__device__ __forceinline__ void ln_stats(const f32x4 (&v)[4], float& mean, float& rstd) {
    float s = 0.f, q = 0.f;
#pragma unroll
    for (int j = 0; j < 4; ++j) { s += (v[j][0] + v[j][1]) + (v[j][2] + v[j][3]); q += (v[j][0] * v[j][0] + v[j][1] * v[j][1]) + (v[j][2] * v[j][2] + v[j][3] * v[j][3]); }
#pragma unroll
    for (int o = 1; o < 64; o <<= 1) { s += __shfl_xor(s, o); q += __shfl_xor(q, o); }
    mean = s * (1.f / D);
    rstd = rsqrtf(fmaxf(q * (1.f / D) - mean * mean, 0.f) + LN_EPS);
}
__device__ __forceinline__ void phase1(PP P, const Ctx& c, bf16_t* H) {
    const float* mod = (const float*)(P->ws + WS_MOD); const float* wg = (const float*)(P->ws + WS_MISC + MISC_WG); float* gates = (float*)(P->ws + WS_GATES);
    f32x4 wgr[8][4];
#pragma unroll
    for (int g = 0; g < 8; ++g)
#pragma unroll
        for (int j = 0; j < 4; ++j) wgr[g][j] = *(const f32x4*)(wg + g * 1024 + 4 * c.lane + 256 * j);
    const int gsel = ((c.lane >> 5) & 1) * 4 + ((c.lane >> 4) & 1) * 2 + ((c.lane >> 3) & 1); const float gbias = P->b_in[2048 + gsel];
    f32x4 nv[4];
    if (c.vw < MT) { const int row = c.vw; const float* xr = row < MP ? P->x_p + (size_t)row * D : P->x_s + (size_t)(row - MP) * D;
#pragma unroll
        for (int j = 0; j < 4; ++j) nv[j] = *(const f32x4*)(xr + 4 * c.lane + 256 * j); }
    int cseq = -1; f32x4 shr[4], scr1[4];
    for (int row = c.vw; row < MT; row += c.nvw) {
        { const int sq = seq_of_row(row); if (sq != cseq) { cseq = sq; const float* mr = mod + (size_t)sq * 6144;
#pragma unroll
            for (int j = 0; j < 4; ++j) { shr[j] = *(const f32x4*)(mr + 4 * c.lane + 256 * j); scr1[j] = *(const f32x4*)(mr + 1024 + 4 * c.lane + 256 * j) + 1.f; } } }
        f32x4 v[4];
#pragma unroll
        for (int j = 0; j < 4; ++j) v[j] = nv[j];
        { const int nr = row + c.nvw; if (nr < MT) { const float* xr = nr < MP ? P->x_p + (size_t)nr * D : P->x_s + (size_t)(nr - MP) * D;
#pragma unroll
            for (int j = 0; j < 4; ++j) nv[j] = *(const f32x4*)(xr + 4 * c.lane + 256 * j); } }
        float mean, rstd; ln_stats(v, mean, rstd);
#pragma unroll
        for (int j = 0; j < 4; ++j) { v[j] = (v[j] - mean) * rstd * scr1[j] + shr[j];
            u32x2 w; w.x = pk2(v[j][0], v[j][1]); w.y = pk2(v[j][2], v[j][3]); *(u32x2*)(H + (size_t)row * D + 4 * c.lane + 256 * j) = w; }
        float gs[8];
#pragma unroll
        for (int g = 0; g < 8; ++g) { float s = 0.f;
#pragma unroll
            for (int j = 0; j < 4; ++j) { const f32x4 w = wgr[g][j]; s += (v[j][0] * w[0] + v[j][1] * w[1]) + (v[j][2] * w[2] + v[j][3] * w[3]); }
            gs[g] = s; }
        { const bool u5 = (c.lane & 32) != 0, u4 = (c.lane & 16) != 0, u3 = (c.lane & 8) != 0; float a4[4], a2[2], a1;
#pragma unroll
          for (int k = 0; k < 4; ++k) { const float send = u5 ? gs[k] : gs[k + 4], keep = u5 ? gs[k + 4] : gs[k]; a4[k] = keep + __shfl_xor(send, 32); }
#pragma unroll
          for (int k = 0; k < 2; ++k) { const float send = u4 ? a4[k] : a4[k + 2], keep = u4 ? a4[k + 2] : a4[k]; a2[k] = keep + __shfl_xor(send, 16); }
          { const float send = u3 ? a2[0] : a2[1], keep = u3 ? a2[1] : a2[0]; a1 = keep + __shfl_xor(send, 8); }
          a1 += __shfl_xor(a1, 4); a1 += __shfl_xor(a1, 2); a1 += __shfl_xor(a1, 1);
          if ((c.lane & 7) == 0) gates[(size_t)row * 8 + gsel] = a1 + gbias; }
    }
}
__device__ __forceinline__ void phase8(PP P, const Ctx& c, bf16_t* H) {
    const float* mod = (const float*)(P->ws + WS_MOD); const bf16_t* XP = (const bf16_t*)(P->ws + WS_XP); bf16_t* X1 = (bf16_t*)(P->ws + WS_X1);
    f32x4 g1v[4], b1v[4];
#pragma unroll
    for (int j = 0; j < 4; ++j) { g1v[j] = *(const f32x4*)(P->ln1g + 4 * c.lane + 256 * j); b1v[j] = *(const f32x4*)(P->ln1b + 4 * c.lane + 256 * j); }
    u32x2 nv[4];
    if (c.vw < MT) {
#pragma unroll
        for (int j = 0; j < 4; ++j) nv[j] = *(const u32x2*)(XP + (size_t)c.vw * D + 4 * c.lane + 256 * j); }
    int cseq = -1; f32x4 shr[4], scr1[4];
    for (int row = c.vw; row < MT; row += c.nvw) {
        { const int sq = seq_of_row(row); if (sq != cseq) { cseq = sq; const float* mr = mod + (size_t)sq * 6144;
#pragma unroll
            for (int j = 0; j < 4; ++j) { shr[j] = *(const f32x4*)(mr + 3072 + 4 * c.lane + 256 * j); scr1[j] = *(const f32x4*)(mr + 4096 + 4 * c.lane + 256 * j) + 1.f; } } }
        f32x4 v[4];
#pragma unroll
        for (int j = 0; j < 4; ++j) v[j] = (f32x4){lo16(nv[j].x), hi16(nv[j].x), lo16(nv[j].y), hi16(nv[j].y)};
        { const int nr = row + c.nvw; if (nr < MT) {
#pragma unroll
            for (int j = 0; j < 4; ++j) nv[j] = *(const u32x2*)(XP + (size_t)nr * D + 4 * c.lane + 256 * j); } }
        float mean, rstd; ln_stats(v, mean, rstd);
#pragma unroll
        for (int j = 0; j < 4; ++j) { v[j] = (v[j] - mean) * rstd * g1v[j] + b1v[j];
            u32x2 w; w.x = pk2(v[j][0], v[j][1]); w.y = pk2(v[j][2], v[j][3]); *(u32x2*)(X1 + (size_t)row * D + 4 * c.lane + 256 * j) = w; }
        ln_stats(v, mean, rstd);
#pragma unroll
        for (int j = 0; j < 4; ++j) { const f32x4 h = (v[j] - mean) * rstd * scr1[j] + shr[j];
            u32x2 w; w.x = pk2(h[0], h[1]); w.y = pk2(h[2], h[3]); *(u32x2*)(H + (size_t)row * D + 4 * c.lane + 256 * j) = w; }
    }
}
__device__ __forceinline__ void phase12(PP P, const Ctx& c) {
    for (int row = MP + c.vw; row < MT; row += c.nvw) {
        float* xr = P->out + (size_t)row * D;
        f32x4 v[4];
#pragma unroll
        for (int j = 0; j < 4; ++j) v[j] = *(const f32x4*)(xr + 4 * c.lane + 256 * j);
        float mean, rstd; ln_stats(v, mean, rstd);
#pragma unroll
        for (int j = 0; j < 4; ++j) { const f32x4 g = *(const f32x4*)(P->ln2g + 4 * c.lane + 256 * j), b = *(const f32x4*)(P->ln2b + 4 * c.lane + 256 * j);
            *(f32x4*)(xr + 4 * c.lane + 256 * j) = (v[j] - mean) * rstd * g + b; }
    }
}

__device__ __forceinline__ float log_sigmoid(float x) { return fminf(x, 0.f) - log1pf(__expf(-fabsf(x))); }
__device__ __forceinline__ void chunk_gates(PP P, float* sm, int row0, int h, const Ctx& c) {
    if (c.wave == 0) {
        const float* gates = (const float*)(P->ws + WS_GATES); const int l = c.lane;
        const float* g0 = gates + (size_t)(row0 + 2 * l) * 8;
        const float f0 = log_sigmoid(g0[4 + h]), f1 = log_sigmoid(g0[12 + h]), i0 = g0[h], i1 = g0[8 + h];
        float x = f0 + f1;
#pragma unroll
        for (int o = 1; o < 64; o <<= 1) { const float t = __shfl_up(x, o); if (l >= o) x += t; }
        const float b1 = x, b0 = x - f1, a0 = i0 - b0, a1 = i1 - b1;
        float m = fmaxf(a0, a1);
#pragma unroll
        for (int o = 1; o < 64; o <<= 1) { const float t = __shfl_up(m, o); if (l >= o) m = fmaxf(m, t); }
        float mp = __shfl_up(m, 1); if (l == 0) mp = -INFINITY;
        *(f32x2*)(sm + 2 * l) = (f32x2){f0, f1}; *(f32x2*)(sm + 128 + 2 * l) = (f32x2){i0, i1}; *(f32x2*)(sm + 256 + 2 * l) = (f32x2){b0, b1};
        *(f32x2*)(sm + 384 + 2 * l) = (f32x2){a0, a1}; *(f32x2*)(sm + 512 + 2 * l) = (f32x2){fmaxf(mp, a0), m};
    }
    __syncthreads();
}
constexpr int LP = 136;

__device__ __forceinline__ void mlstm_local_unit(PP P, unsigned char* lds, const Ctx& c, int unit) {
    const int bh = unit >> 6, ch = unit & 63, b = bh >> 2, h = bh & 3, row0 = b * SEQ + ch * 128;
    bf16_t* vT = (bf16_t*)lds; bf16_t* kT = (bf16_t*)(lds + 256 * LP * 2); float* sm = (float*)(lds + 384 * LP * 2); float* sw = sm + 640;
    const bf16_t* Z0 = (const bf16_t*)(P->ws + WS_Z0); const bf16_t* Z1 = (const bf16_t*)(P->ws + WS_Z1);
    u32x4 rv[8], rkk[4];
#pragma unroll
    for (int i = 0; i < 8; ++i) { const int s = (c.lane >> 1) + 32 * (i & 3), c8 = 4 * c.wave + 2 * (i >> 2) + (c.lane & 1); rv[i] = *(const u32x4*)(Z1 + (size_t)(row0 + s) * 2048 + 256 * h + 8 * c8); }
#pragma unroll
    for (int i = 0; i < 4; ++i) { const int s = (c.lane >> 1) + 32 * i, c8 = 2 * c.wave + (c.lane & 1); rkk[i] = *(const u32x4*)(Z0 + (size_t)(row0 + s) * 1024 + 512 + 128 * h + 8 * c8); }
    chunk_gates(P, sm, row0, h, c);
    const float AT = sm[512 + 127], bT = sm[256 + 127];
    if (c.tid < 128) sw[c.tid] = __expf(sm[384 + c.tid] - AT);
    if (c.tid == 0) { float* chs = (float*)(P->ws + WS_MISC + MISC_CH); chs[(bh * 64 + ch) * 2] = bT; chs[(bh * 64 + ch) * 2 + 1] = AT; }
    __syncthreads();
#pragma unroll
    for (int i = 0; i < 8; ++i) { const int s = (c.lane >> 1) + 32 * (i & 3), c8 = 4 * c.wave + 2 * (i >> 2) + (c.lane & 1); const u32x4 x = rv[i]; const float w = sw[s];
#pragma unroll
        for (int q = 0; q < 4; ++q) { vT[(8 * c8 + 2 * q) * LP + s] = (bf16_t)f2bf(lo16(x[q]) * w); vT[(8 * c8 + 2 * q + 1) * LP + s] = (bf16_t)f2bf(hi16(x[q]) * w); } }
#pragma unroll
    for (int i = 0; i < 4; ++i) { const int s = (c.lane >> 1) + 32 * i, c8 = 2 * c.wave + (c.lane & 1); const u32x4 x = rkk[i];
#pragma unroll
        for (int q = 0; q < 4; ++q) { kT[(8 * c8 + 2 * q) * LP + s] = (bf16_t)(x[q] & 0xffffu); kT[(8 * c8 + 2 * q + 1) * LP + s] = (bf16_t)(x[q] >> 16); } }
    __syncthreads();
    { const int d = c.tid & 127, part = c.tid >> 7; float s = 0.f;
#pragma unroll
      for (int i = 0; i < 4; ++i) { const u32x4 x = *(const u32x4*)(kT + d * LP + 32 * part + 8 * i);
#pragma unroll
          for (int q = 0; q < 4; ++q) s += lo16(x[q]) * sw[32 * part + 8 * i + 2 * q] + hi16(x[q]) * sw[32 * part + 8 * i + 2 * q + 1]; }
      sw[128 + c.tid] = s; }
    const int ql = c.lane & 31, hh = c.lane >> 5;
    f32x16 acc[4];
#pragma unroll
    for (int i = 0; i < 4; ++i)
#pragma unroll
        for (int r = 0; r < 16; ++r) acc[i][r] = 0.f;
#pragma unroll
    for (int ks = 0; ks < 8; ++ks) { const bf16x8 bv = *(const bf16x8*)(vT + (32 * c.wave + ql) * LP + 16 * ks + 8 * hh);
#pragma unroll
        for (int i = 0; i < 4; ++i) { const bf16x8 ak = *(const bf16x8*)(kT + (32 * i + ql) * LP + 16 * ks + 8 * hh); acc[i] = __builtin_amdgcn_mfma_f32_32x32x16_bf16(ak, bv, acc[i], 0, 0, 0); } }
    bf16_t* U = (bf16_t*)P->out + (size_t)(bh * 64 + ch) * 32768 + (size_t)(32 * c.wave + ql) * 128;
#pragma unroll
    for (int i = 0; i < 4; ++i)
#pragma unroll
        for (int g4 = 0; g4 < 4; ++g4) { u32x2 w; w.x = pk2(acc[i][4 * g4], acc[i][4 * g4 + 1]); w.y = pk2(acc[i][4 * g4 + 2], acc[i][4 * g4 + 3]); *(u32x2*)(U + 32 * i + 8 * g4 + 4 * hh) = w; }
    __syncthreads();
    if (c.tid < 128) ((float*)(P->ws + WS_MISC + MISC_UN))[(size_t)(bh * 64 + ch) * 128 + c.tid] = (sw[128 + c.tid] + sw[256 + c.tid]) + (sw[384 + c.tid] + sw[512 + c.tid]);
    __syncthreads();
}

__device__ __forceinline__ void swa_prompt_unit(PP P, unsigned char* lds, const Ctx& c, int unit) {
    const int qb = unit & 127, kvh = (unit >> 7) & 3, b = unit >> 9, q0 = qb * 64, key0 = q0 - 128;
    bf16_t* Ks = (bf16_t*)lds; bf16_t* VT = (bf16_t*)(lds + 192 * 72 * 2);
    bf16_t* Z1 = (bf16_t*)(P->ws + WS_Z1); const bf16_t* Z2 = (const bf16_t*)(P->ws + WS_Z2);
#pragma unroll
    for (int i = 0; i < 3; ++i) { const int key = (c.lane >> 1) + 32 * (2 * i + (c.wave >> 2)), c8 = 2 * (c.wave & 3) + (c.lane & 1), kpos = key0 + key;
        u32x4 kx = (u32x4){0u, 0u, 0u, 0u}, vx = kx;
        if (kpos >= 0) { const bf16_t* rp = Z2 + (size_t)(b * SEQ + kpos) * 512 + kvh * 64 + 8 * c8; kx = *(const u32x4*)rp; vx = *(const u32x4*)(rp + 256); }
        *(u32x4*)(Ks + key * 72 + 8 * c8) = kx;
#pragma unroll
        for (int q = 0; q < 4; ++q) { VT[(8 * c8 + 2 * q) * 200 + key] = (bf16_t)(vx[q] & 0xffffu); VT[(8 * c8 + 2 * q + 1) * 200 + key] = (bf16_t)(vx[q] >> 16); } }
    __syncthreads();
    const int g = c.wave & 3, half = c.wave >> 2, head = 4 * kvh + g, ql = c.lane & 31, hh = c.lane >> 5;
    const size_t qrow = (size_t)b * SEQ + q0 + 32 * half + ql;
    bf16_t* qp = Z1 + qrow * 2048 + 1024 + head * 64;
    bf16x8 qf[4];
#pragma unroll
    for (int ks = 0; ks < 4; ++ks) qf[ks] = *(const bf16x8*)(qp + 16 * ks + 8 * hh);
    f32x16 st[5];
#pragma unroll
    for (int kt = 0; kt < 5; ++kt) {
#pragma unroll
        for (int r = 0; r < 16; ++r) st[kt][r] = 0.f;
#pragma unroll
        for (int ks = 0; ks < 4; ++ks) { const bf16x8 a = *(const bf16x8*)(Ks + (32 * half + 32 * kt + ql) * 72 + 16 * ks + 8 * hh); st[kt] = __builtin_amdgcn_mfma_f32_32x32x16_bf16(a, qf[ks], st[kt], 0, 0, 0); } }
    const float slope = exp2f(-0.5f * (float)(head + 1)), sink = P->sinks[head];
    float mx = sink;
    {
        const float nsl = -slope, bf = (float)(ql - 4 * hh); const int qh = ql - 4 * hh, kp0 = q0 + 32 * half - 128 + 4 * hh; const bool edge = q0 < 128;
#pragma unroll
        for (int kt = 0; kt < 5; ++kt)
#pragma unroll
            for (int r = 0; r < 16; ++r) { const int kc = (r & 3) + 8 * (r >> 2);
                float s = nsl * (bf + (float)(128 - 32 * kt - kc)) + st[kt][r];
                if (kt == 0) s = (kc > qh) ? s : -INFINITY;
                if (kt == 4) s = (kc <= qh) ? s : -INFINITY;
                if (edge && kt < 4) s = (kp0 + 32 * kt + kc >= 0) ? s : -INFINITY;
                st[kt][r] = s; mx = fmaxf(mx, s); } }
    mx = fmaxf(mx, __shfl_xor(mx, 32));
    float sum = 0.f;
#pragma unroll
    for (int kt = 0; kt < 5; ++kt)
#pragma unroll
        for (int r = 0; r < 16; ++r) { const float p = __expf(st[kt][r] - mx); st[kt][r] = p; sum += p; }
    sum += __shfl_xor(sum, 32);
    const float inv = 1.f / (sum + __expf(sink - mx));
    f32x16 ot[2];
#pragma unroll
    for (int db = 0; db < 2; ++db)
#pragma unroll
        for (int r = 0; r < 16; ++r) ot[db][r] = 0.f;
#pragma unroll
    for (int kt = 0; kt < 5; ++kt)
#pragma unroll
        for (int a2 = 0; a2 < 2; ++a2) { bf16x8 pb;
#pragma unroll
            for (int j = 0; j < 8; ++j) pb[j] = (short)f2bf(st[kt][8 * a2 + j]);
#pragma unroll
            for (int db = 0; db < 2; ++db) { const bf16_t* vp = VT + (32 * db + ql) * 200 + 32 * half + 32 * kt + 16 * a2 + 4 * hh;
                const u32x2 v0 = *(const u32x2*)vp, v1 = *(const u32x2*)(vp + 8); u32x4 vv; vv.x = v0.x; vv.y = v0.y; vv.z = v1.x; vv.w = v1.y;
                ot[db] = __builtin_amdgcn_mfma_f32_32x32x16_bf16(__builtin_bit_cast(bf16x8, vv), pb, ot[db], 0, 0, 0); } }
#pragma unroll
    for (int db = 0; db < 2; ++db)
#pragma unroll
        for (int g4 = 0; g4 < 4; ++g4) { const int d = 32 * db + 8 * g4 + 4 * hh; u32x2 w; w.x = pk2(ot[db][4 * g4] * inv, ot[db][4 * g4 + 1] * inv); w.y = pk2(ot[db][4 * g4 + 2] * inv, ot[db][4 * g4 + 3] * inv);
            *(u32x2*)(qp + d) = w; }
    __syncthreads();
}

__device__ __forceinline__ void mlstm_sample_unit(PP P, unsigned char* lds, const Ctx& c, int unit) {
    const int b = unit >> 2, h = unit & 3, row0 = MP + 4 * b, tid = c.tid;
    float* sq = (float*)lds; float* sk = sq + 512; float* sv = sk + 512; float* sqk = sv + 1024; float* snq = sqk + 16; float* shv = snq + 4;
    const float* gates = (const float*)(P->ws + WS_GATES); const bf16_t* Z0 = (const bf16_t*)(P->ws + WS_Z0); bf16_t* Z1 = (bf16_t*)(P->ws + WS_Z1); const bf16_t* Z3 = (const bf16_t*)(P->ws + WS_Z3);
    const int chunk = tid & 31, rbase = tid >> 5; const size_t cbase = (size_t)(b * 4 + h) * 32768 + 4 * chunk;
    f32x4 cA[8];
#pragma unroll
    for (int j = 0; j < 8; ++j) cA[j] = *(const f32x4*)(P->st_C + cbase + (size_t)(rbase + 16 * j) * 128);
    float ig[4], bb[4], aa[4], AA[4], Mt[4], ain[4], einv[4], wsv[4];
    { float run = 0.f, mxa = -INFINITY;
#pragma unroll
      for (int t = 0; t < 4; ++t) { ig[t] = gates[(size_t)(row0 + t) * 8 + h]; run += log_sigmoid(gates[(size_t)(row0 + t) * 8 + 4 + h]); bb[t] = run; aa[t] = ig[t] - run; mxa = fmaxf(mxa, aa[t]); AA[t] = mxa; } }
    const float m0 = P->st_m[b * 4 + h];
#pragma unroll
    for (int t = 0; t < 4; ++t) { Mt[t] = fmaxf(m0, AA[t]); ain[t] = __expf(m0 - Mt[t]); einv[t] = __expf(-(bb[t] + Mt[t])); }
    const float MTl = Mt[3], decay = __expf(m0 - MTl), m_new = bb[3] + MTl;
#pragma unroll
    for (int s = 0; s < 4; ++s) wsv[s] = __expf(aa[s] - MTl);
    { const int t = tid >> 7, d = tid & 127; sq[tid] = bf2f(Z0[(size_t)(row0 + t) * 1024 + 128 * h + d]); sk[tid] = bf2f(Z0[(size_t)(row0 + t) * 1024 + 512 + 128 * h + d]);
#pragma unroll
      for (int i = 0; i < 2; ++i) { const int id = tid + 512 * i, tt = id >> 8, vc = id & 255; sv[id] = bf2f(Z1[(size_t)(row0 + tt) * 2048 + 256 * h + vc]); } }
    __syncthreads();
    { const float* n0 = P->st_n + (size_t)(b * 4 + h) * 128;
#pragma unroll
      for (int k = 0; k < 3; ++k) { const int i = c.wave + 8 * k;
          if (i < 20) { float p;
              if (i < 16) { const int t = i >> 2, s = i & 3; p = sq[t * 128 + c.lane] * sk[s * 128 + c.lane] + sq[t * 128 + 64 + c.lane] * sk[s * 128 + 64 + c.lane]; }
              else { const int t = i - 16; p = n0[c.lane] * sq[t * 128 + c.lane] + n0[64 + c.lane] * sq[t * 128 + 64 + c.lane]; }
              p = wave_sum(p); if (c.lane == 0) { if (i < 16) sqk[i] = p; else snq[i - 16] = p; } } } }
    __syncthreads();
    float smat[4][4], dinv[4];
#pragma unroll
    for (int t = 0; t < 4; ++t) { float den = 0.f;
#pragma unroll
        for (int s = 0; s < 4; ++s) { smat[t][s] = (s <= t) ? sqk[t * 4 + s] * __expf(aa[s] - Mt[t]) : 0.f; den += smat[t][s]; }
        den += ain[t] * snq[t]; dinv[t] = 1.f / fmaxf(fabsf(den), einv[t]); }
    {
      f32x4 cB[8];
#pragma unroll
      for (int j = 0; j < 8; ++j) cB[j] = *(const f32x4*)(P->st_C + cbase + (size_t)(rbase + 16 * (j + 8)) * 128);
      f32x4 q4[4], k4[4];
#pragma unroll
      for (int t = 0; t < 4; ++t) { q4[t] = *(const f32x4*)(sq + t * 128 + 4 * chunk); k4[t] = *(const f32x4*)(sk + t * 128 + 4 * chunk); }
#pragma unroll
      for (int j = 0; j < 16; ++j) { const int row = rbase + 16 * j;
          const f32x4 c4 = j < 8 ? cA[j & 7] : cB[j & 7];
          float p[4]; f32x4 nw = c4 * decay;
#pragma unroll
          for (int t = 0; t < 4; ++t) { p[t] = (c4[0] * q4[t][0] + c4[1] * q4[t][1]) + (c4[2] * q4[t][2] + c4[3] * q4[t][3]); nw = nw + k4[t] * (wsv[t] * sv[t * 256 + row]); }
          *(f32x4*)(P->out + O_SC + cbase + (size_t)row * 128) = nw;
#pragma unroll
          for (int o = 1; o < 32; o <<= 1) {
#pragma unroll
              for (int t = 0; t < 4; ++t) p[t] += __shfl_xor(p[t], o); }
          if (chunk == 0) {
#pragma unroll
              for (int t = 0; t < 4; ++t) { float num = ain[t] * p[t];
#pragma unroll
                  for (int s = 0; s < 4; ++s) num += smat[t][s] * sv[s * 256 + row];
                  shv[t * 256 + row] = num * dinv[t]; } } } }
    if (tid < 128) { const float* n0 = P->st_n + (size_t)(b * 4 + h) * 128; float a = decay * n0[tid];
#pragma unroll
        for (int s = 0; s < 4; ++s) a += wsv[s] * sk[s * 128 + tid];
        P->out[O_SN + (size_t)(b * 4 + h) * 128 + tid] = a; }
    if (tid == 0) P->out[O_SM + b * 4 + h] = m_new;
    __syncthreads();
    if (c.wave < 4) { const int t = c.wave; float x[4], s = 0.f;
#pragma unroll
        for (int i = 0; i < 4; ++i) { x[i] = shv[t * 256 + c.lane + 64 * i]; s += x[i]; }
        const float mean = wave_sum(s) * (1.f / 256.f); float q = 0.f;
#pragma unroll
        for (int i = 0; i < 4; ++i) { x[i] -= mean; q += x[i] * x[i]; }
        const float rstd = 1.f / sqrtf(wave_sum(q) * (1.f / 256.f) + LN_EPS);
#pragma unroll
        for (int i = 0; i < 4; ++i) { const int vc = 256 * h + c.lane + 64 * i; const float og = bf2f(Z3[(size_t)(row0 + t) * 1024 + vc]);
            Z1[(size_t)(row0 + t) * 2048 + vc] = (bf16_t)f2bf(x[i] * rstd * P->mnorm[vc] * og); } }
    __syncthreads();
}

__device__ __forceinline__ void swa_sample_unit(PP P, unsigned char* lds, const Ctx& c, int unit) {
    const int b = unit >> 2, kvh = unit & 3, row0 = MP + 4 * b, tid = c.tid;
    constexpr int KP = 68;
    float* sK = (float*)lds; float* sV = sK + 132 * KP; float* sQ = sV + 132 * KP; float* sP = sQ + 1024;
    bf16_t* Z1 = (bf16_t*)(P->ws + WS_Z1); const bf16_t* Z2 = (const bf16_t*)(P->ws + WS_Z2);
    { f32x4 kx[4], vx[4];
#pragma unroll
      for (int i = 0; i < 4; ++i) { const int j = tid + 512 * i, idx = j >> 4, d4 = j & 15; const size_t o = ((size_t)(b * 128 + idx) * 4 + kvh) * 64 + 4 * d4; kx[i] = *(const f32x4*)(P->ck + o); vx[i] = *(const f32x4*)(P->cv + o); }
#pragma unroll
      for (int i = 0; i < 4; ++i) { const int j = tid + 512 * i, idx = j >> 4, d4 = j & 15;
          *(f32x4*)(sK + idx * KP + 4 * d4) = kx[i]; *(f32x4*)(sV + idx * KP + 4 * d4) = vx[i];
          if (idx >= 4) { const size_t o = ((size_t)(b * 128 + idx - 4) * 4 + kvh) * 64 + 4 * d4; *(f32x4*)(P->out + O_SK + o) = kx[i]; *(f32x4*)(P->out + O_SV + o) = vx[i]; } }
      if (tid < 256) { const int r = tid >> 6, d = tid & 63; const bf16_t* rp = Z2 + (size_t)(row0 + r) * 512 + kvh * 64 + d; const float kv = bf2f(rp[0]), vv = bf2f(rp[256]);
          sK[(128 + r) * KP + d] = kv; sV[(128 + r) * KP + d] = vv; const size_t o = ((size_t)(b * 128 + 124 + r) * 4 + kvh) * 64 + d; P->out[O_SK + o] = kv; P->out[O_SV + o] = vv; } }
#pragma unroll
    for (int i = 0; i < 2; ++i) { const int id = tid + 512 * i, pair = id >> 6, d = id & 63, t = pair >> 2, g = pair & 3; sQ[id] = bf2f(Z1[(size_t)(row0 + t) * 2048 + 1024 + (4 * kvh + g) * 64 + d]); }
    __syncthreads();
    for (int id = tid; id < 16 * 132; id += 512) { const int pair = id / 132, idx = id % 132, t = pair >> 2, g = pair & 3, delta = 128 + t - idx;
        float s = -INFINITY;
        if (delta >= 0 && delta < 128) { float a = 0.f;
#pragma unroll
            for (int cc = 0; cc < 16; ++cc) { const f32x4 q = *(const f32x4*)(sQ + pair * 64 + 4 * cc), k = *(const f32x4*)(sK + idx * KP + 4 * cc); a += (q[0] * k[0] + q[1] * k[1]) + (q[2] * k[2] + q[3] * k[3]); }
            s = a - exp2f(-0.5f * (float)(4 * kvh + g + 1)) * (float)delta; }
        sP[id] = s; }
    __syncthreads();
#pragma unroll
    for (int pp = 0; pp < 2; ++pp) { const int pair = 2 * c.wave + pp, g = pair & 3; const float sink = P->sinks[4 * kvh + g];
        float x[3], mx = sink;
#pragma unroll
        for (int i = 0; i < 3; ++i) { const int idx = c.lane + 64 * i; x[i] = idx < 132 ? sP[pair * 132 + idx] : -INFINITY; mx = fmaxf(mx, x[i]); }
        mx = wave_max(mx); float sum = 0.f;
#pragma unroll
        for (int i = 0; i < 3; ++i) { x[i] = __expf(x[i] - mx); sum += x[i]; }
        const float inv = 1.f / (wave_sum(sum) + __expf(sink - mx));
#pragma unroll
        for (int i = 0; i < 3; ++i) { const int idx = c.lane + 64 * i; if (idx < 132) sP[pair * 132 + idx] = x[i] * inv; } }
    __syncthreads();
    {
        const int pair = tid >> 5, hf = (tid >> 4) & 1, d4 = tid & 15, t = pair >> 2, g = pair & 3;
        f32x4 o = (f32x4){0.f, 0.f, 0.f, 0.f};
#pragma unroll 6
        for (int i = 0; i < 66; ++i) { const int idx = 66 * hf + i; o = o + *(const f32x4*)(sV + idx * KP + 4 * d4) * sP[pair * 132 + idx]; }
#pragma unroll
        for (int e = 0; e < 4; ++e) o[e] += __shfl_xor(o[e], 16);
        if (hf == 0) { u32x2 w; w.x = pk2(o[0], o[1]); w.y = pk2(o[2], o[3]); *(u32x2*)(Z1 + (size_t)(row0 + t) * 2048 + 1024 + (4 * kvh + g) * 64 + 4 * d4) = w; } }
    __syncthreads();
}

__device__ __forceinline__ void phase3(PP P, unsigned char* lds, const Ctx& c) {
    { const bf16_t* Z2 = (const bf16_t*)(P->ws + WS_Z2);
      for (int i = blockIdx.x * 512 + c.tid; i < 2 * 128 * 512; i += gridDim.x * 512) { const int cc = i & 511, r = (i >> 9) & 127, b = i >> 16;
          const float v = bf2f(Z2[(size_t)(b * SEQ + SEQ - 128 + r) * 512 + cc]);
          if (cc < 256) P->out[O_PK + (size_t)(b * 128 + r) * 256 + cc] = v; else P->out[O_PV + (size_t)(b * 128 + r) * 256 + cc - 256] = v; } }
    if ((blockIdx.x >> 3) & 1) {
        for (int u = blockIdx.x; u < 512; u += gridDim.x) mlstm_sample_unit(P, lds, c, u);
        for (int u = blockIdx.x; u < 512; u += gridDim.x) swa_sample_unit(P, lds, c, u);
        for (int u = blockIdx.x; u < 512; u += gridDim.x) mlstm_local_unit(P, lds, c, u);
        for (int u = blockIdx.x; u < 1024; u += gridDim.x) swa_prompt_unit(P, lds, c, u);
    } else {
        for (int u = blockIdx.x; u < 512; u += gridDim.x) mlstm_local_unit(P, lds, c, u);
        for (int u = blockIdx.x; u < 1024; u += gridDim.x) swa_prompt_unit(P, lds, c, u);
        for (int u = blockIdx.x; u < 512; u += gridDim.x) mlstm_sample_unit(P, lds, c, u);
        for (int u = blockIdx.x; u < 512; u += gridDim.x) swa_sample_unit(P, lds, c, u);
    }
}

__device__ __forceinline__ void phase4(PP P, unsigned char* lds, const Ctx& c) {
    float* sal = (float*)lds; float* sbe = sal + 64;
    const float* chs = (const float*)(P->ws + WS_MISC + MISC_CH); float* mc = (float*)(P->ws + WS_MISC + MISC_MC); float* un = (float*)(P->ws + WS_MISC + MISC_UN);
    for (int vb = blockIdx.x; vb < 256; vb += gridDim.x) {
        const int bh = vb >> 5, part = vb & 31;
        __syncthreads();
        if (c.tid < 128) sbe[64 + c.tid] = chs[bh * 128 + c.tid];
        __syncthreads();
        if (c.tid == 0) { float m = 0.f;
            for (int ch = 0; ch < 64; ++ch) { sbe[192 + ch] = m; m = sbe[64 + 2 * ch] + fmaxf(m, sbe[65 + 2 * ch]); }
            sbe[256] = m; }
        __syncthreads();
        if (c.tid < 64) { const float m = sbe[192 + c.tid], AT = sbe[65 + 2 * c.tid], Mc = fmaxf(m, AT); sal[c.tid] = __expf(m - Mc); sbe[c.tid] = __expf(AT - Mc); if (part == 0) mc[bh * 65 + c.tid] = m; }
        if (c.tid == 64 && part == 0) { const float m = sbe[256]; mc[bh * 65 + 64] = m; P->out[O_PM + bh] = m; }
        __syncthreads();
        { const int e = part * 1024 + 2 * c.tid; unsigned* U = (unsigned*)((bf16_t*)P->out + (size_t)bh * 64 * 32768 + e); f32x2 C = (f32x2){0.f, 0.f};
#pragma unroll 16
          for (int ch = 0; ch < 64; ++ch) { unsigned* p = U + (size_t)ch * 16384; const unsigned u = *p; *p = pk2(C[0], C[1]); C[0] = C[0] * sal[ch] + lo16(u) * sbe[ch]; C[1] = C[1] * sal[ch] + hi16(u) * sbe[ch]; }
          *(f32x2*)(P->out + O_PC + (size_t)bh * 32768 + e) = C; }
        if (part == 0 && c.tid < 128) { float n = 0.f; float uu[64];
#pragma unroll
            for (int ch = 0; ch < 64; ++ch) uu[ch] = un[(size_t)(bh * 64 + ch) * 128 + c.tid];
#pragma unroll
            for (int ch = 0; ch < 64; ++ch) { un[(size_t)(bh * 64 + ch) * 128 + c.tid] = n; n = n * sal[ch] + uu[ch] * sbe[ch]; }
            P->out[O_PN + bh * 128 + c.tid] = n; }
    }
}

__device__ __forceinline__ void mlstm_out_unit(PP P, unsigned char* lds, const Ctx& c, int unit) {
    const int bh = unit >> 6, ch = unit & 63, b = bh >> 2, h = bh & 3, row0 = b * SEQ + ch * 128, tid = c.tid;
    bf16_t* Ql = (bf16_t*)lds; bf16_t* Kl = (bf16_t*)(lds + 128 * LP * 2); bf16_t* Cl = (bf16_t*)(lds + 256 * LP * 2);
    float* sm = (float*)(lds + 512 * LP * 2);
    float* sMt = sm + 640; float* sain = sMt + 128; float* seinv = sain + 128; float* sdinv = seinv + 128; float* sn = sdinv + 128; float* spart = sn + 128;
    const bf16_t* Z0 = (const bf16_t*)(P->ws + WS_Z0); bf16_t* Z1 = (bf16_t*)(P->ws + WS_Z1); const bf16_t* Z3 = (const bf16_t*)(P->ws + WS_Z3);
    u32x4 rq[4], rk[4], rc[8];
#pragma unroll
    for (int i = 0; i < 4; ++i) { const int id = tid + 512 * i, t = id >> 4, c8 = id & 15; const bf16_t* rp = Z0 + (size_t)(row0 + t) * 1024 + 128 * h + 8 * c8; rq[i] = *(const u32x4*)rp; rk[i] = *(const u32x4*)(rp + 512); }
    { const bf16_t* Cs = (const bf16_t*)P->out + (size_t)(bh * 64 + ch) * 32768;
#pragma unroll
      for (int i = 0; i < 8; ++i) { const int id = tid + 512 * i, v = id >> 4, c8 = id & 15; rc[i] = *(const u32x4*)(Cs + v * 128 + 8 * c8); } }
    chunk_gates(P, sm, row0, h, c);
    const float mcv = ((const float*)(P->ws + WS_MISC + MISC_MC))[bh * 65 + ch];
    if (tid < 128) { const float Mt = fmaxf(mcv, sm[512 + tid]); sMt[tid] = Mt; sain[tid] = __expf(mcv - Mt); seinv[tid] = __expf(-(sm[256 + tid] + Mt));
        sn[tid] = ((const float*)(P->ws + WS_MISC + MISC_UN))[(size_t)(bh * 64 + ch) * 128 + tid]; }
#pragma unroll
    for (int i = 0; i < 4; ++i) { const int id = tid + 512 * i, t = id >> 4, c8 = id & 15; *(u32x4*)(Ql + t * LP + 8 * c8) = rq[i]; *(u32x4*)(Kl + t * LP + 8 * c8) = rk[i]; }
#pragma unroll
    for (int i = 0; i < 8; ++i) { const int id = tid + 512 * i, v = id >> 4, c8 = id & 15; *(u32x4*)(Cl + v * LP + 8 * c8) = rc[i]; }
    __syncthreads();
    const int ql = c.lane & 31, hh = c.lane >> 5;
    { const int sb = c.wave & 3, th = c.wave >> 2;
      f32x16 sacc[2];
#pragma unroll
      for (int j = 0; j < 2; ++j) {
#pragma unroll
          for (int r = 0; r < 16; ++r) sacc[j][r] = 0.f;
          const int tt = 2 * th + j;
          if (tt >= sb) {
#pragma unroll
              for (int ks = 0; ks < 8; ++ks) { const bf16x8 a = *(const bf16x8*)(Kl + (32 * sb + ql) * LP + 16 * ks + 8 * hh), bq = *(const bf16x8*)(Ql + (32 * tt + ql) * LP + 16 * ks + 8 * hh);
                  sacc[j] = __builtin_amdgcn_mfma_f32_32x32x16_bf16(a, bq, sacc[j], 0, 0, 0); } } }
      __syncthreads();
#pragma unroll
      for (int j = 0; j < 2; ++j) { const int t = 32 * (2 * th + j) + ql; const float Mt = sMt[t];
#pragma unroll
          for (int g4 = 0; g4 < 4; ++g4) { float v[4];
#pragma unroll
              for (int e = 0; e < 4; ++e) { const int s = 32 * sb + 8 * g4 + 4 * hh + e; v[e] = (s <= t) ? sacc[j][4 * g4 + e] * __expf(sm[384 + s] - Mt) : 0.f; }
              u32x2 w; w.x = pk2(v[0], v[1]); w.y = pk2(v[2], v[3]); *(u32x2*)(Kl + t * LP + 32 * sb + 8 * g4 + 4 * hh) = w; } } }
    __syncthreads();
    { const int t = tid >> 2, part = tid & 3; float ss = 0.f, nq = 0.f;
      for (int i = 0; i < 32; ++i) { ss += bf2f(Kl[t * LP + 32 * part + i]); nq += bf2f(Ql[t * LP + 32 * part + i]) * sn[32 * part + i]; }
      ss += __shfl_xor(ss, 1); ss += __shfl_xor(ss, 2); nq += __shfl_xor(nq, 1); nq += __shfl_xor(nq, 2);
      if (part == 0) sdinv[t] = 1.f / fmaxf(fabsf(ss + sain[t] * nq), seinv[t]); }
    const int tb = c.wave & 3, vh = c.wave >> 2;
    f32x16 acc[4];
#pragma unroll
    for (int i = 0; i < 4; ++i)
#pragma unroll
        for (int r = 0; r < 16; ++r) acc[i][r] = 0.f;
#pragma unroll
    for (int ks = 0; ks < 8; ++ks) { const bf16x8 bq = *(const bf16x8*)(Ql + (32 * tb + ql) * LP + 16 * ks + 8 * hh);
#pragma unroll
        for (int i = 0; i < 4; ++i) { const bf16x8 a = *(const bf16x8*)(Cl + (32 * (4 * vh + i) + ql) * LP + 16 * ks + 8 * hh); acc[i] = __builtin_amdgcn_mfma_f32_32x32x16_bf16(a, bq, acc[i], 0, 0, 0); } }
    { const float ai = sain[32 * tb + ql];
#pragma unroll
      for (int i = 0; i < 4; ++i) acc[i] = acc[i] * ai; }
    __syncthreads();
#pragma unroll
    for (int i = 0; i < 8; ++i) { const int s = (c.lane >> 1) + 32 * (i & 3), c8 = 4 * c.wave + 2 * (i >> 2) + (c.lane & 1); const u32x4 x = *(const u32x4*)(Z1 + (size_t)(row0 + s) * 2048 + 256 * h + 8 * c8);
#pragma unroll
        for (int q = 0; q < 4; ++q) { Cl[(8 * c8 + 2 * q) * LP + s] = (bf16_t)(x[q] & 0xffffu); Cl[(8 * c8 + 2 * q + 1) * LP + s] = (bf16_t)(x[q] >> 16); } }
    __syncthreads();
    for (int ks = 0; ks < 2 * (tb + 1); ++ks) { const bf16x8 bs = *(const bf16x8*)(Kl + (32 * tb + ql) * LP + 16 * ks + 8 * hh);
#pragma unroll
        for (int i = 0; i < 4; ++i) { const bf16x8 a = *(const bf16x8*)(Cl + (32 * (4 * vh + i) + ql) * LP + 16 * ks + 8 * hh); acc[i] = __builtin_amdgcn_mfma_f32_32x32x16_bf16(a, bs, acc[i], 0, 0, 0); } }
    const int t = 32 * tb + ql; const float dinv = sdinv[t];
    float s1 = 0.f, s2 = 0.f;
#pragma unroll
    for (int i = 0; i < 4; ++i)
#pragma unroll
        for (int r = 0; r < 16; ++r) { const float x = acc[i][r] * dinv; acc[i][r] = x; s1 += x; s2 += x * x; }
    s1 += __shfl_xor(s1, 32); s2 += __shfl_xor(s2, 32);
    if (hh == 0) { spart[(vh * 128 + t) * 2] = s1; spart[(vh * 128 + t) * 2 + 1] = s2; }
    __syncthreads();
    const float mean = (spart[t * 2] + spart[(128 + t) * 2]) * (1.f / 256.f), ex2 = (spart[t * 2 + 1] + spart[(128 + t) * 2 + 1]) * (1.f / 256.f);
    const float rstd = 1.f / sqrtf(fmaxf(ex2 - mean * mean, 0.f) + LN_EPS);
    bf16_t* Tl = (bf16_t*)lds; constexpr int TP = 264;
#pragma unroll
    for (int i = 0; i < 4; ++i)
#pragma unroll
        for (int g4 = 0; g4 < 4; ++g4) { const int v0 = 32 * (4 * vh + i) + 8 * g4 + 4 * hh; u32x2 w;
            w.x = pk2((acc[i][4 * g4] - mean) * rstd, (acc[i][4 * g4 + 1] - mean) * rstd); w.y = pk2((acc[i][4 * g4 + 2] - mean) * rstd, (acc[i][4 * g4 + 3] - mean) * rstd);
            *(u32x2*)(Tl + t * TP + v0) = w; }
    __syncthreads();
#pragma unroll
    for (int k = 0; k < 8; ++k) { const int id = tid + 512 * k, t2 = id >> 5, ch = id & 31, vc = 256 * h + 8 * ch;
        const u32x4 x = *(const u32x4*)(Tl + t2 * TP + 8 * ch), og = *(const u32x4*)(Z3 + (size_t)(row0 + t2) * 1024 + vc);
        const f32x4 n0 = *(const f32x4*)(P->mnorm + vc), n1 = *(const f32x4*)(P->mnorm + vc + 4);
        u32x4 w;
        w.x = pk2(lo16(x.x) * n0[0] * lo16(og.x), hi16(x.x) * n0[1] * hi16(og.x));
        w.y = pk2(lo16(x.y) * n0[2] * lo16(og.y), hi16(x.y) * n0[3] * hi16(og.y));
        w.z = pk2(lo16(x.z) * n1[0] * lo16(og.z), hi16(x.z) * n1[1] * hi16(og.z));
        w.w = pk2(lo16(x.w) * n1[2] * lo16(og.w), hi16(x.w) * n1[3] * hi16(og.w));
        *(u32x4*)(Z1 + (size_t)(row0 + t2) * 2048 + vc) = w; }
    __syncthreads();
}

template <int NH>
__device__ __forceinline__ void small_gemm_tile(const bf16_t* A, int lda, const bf16_t* Bt, int ldb, int KH, int row0, int col0, unsigned char* lds, const Ctx& c, float (&res)[NH][4]) {
    const int ql = c.lane & 31, hh = c.lane >> 5, kw = KH >> 3, nks = kw >> 4;
    float* red = (float*)lds;
    f32x16 acc[NH][2];
#pragma unroll
    for (int h = 0; h < NH; ++h)
#pragma unroll
        for (int ct = 0; ct < 2; ++ct)
#pragma unroll
            for (int r = 0; r < 16; ++r) acc[h][ct][r] = 0.f;
    const bf16_t* ap = A + (size_t)(row0 + ql) * lda + c.wave * kw + 8 * hh;
    const bf16_t* bp0 = Bt + (size_t)(col0 + ql) * ldb + c.wave * kw + 8 * hh;
    const bf16_t* bp1 = bp0 + (size_t)32 * ldb;
#pragma unroll
    for (int h = 0; h < NH; ++h) {
#pragma unroll 4
        for (int ks = 0; ks < nks; ++ks) { const int k = h * KH + 16 * ks;
            const bf16x8 a = *(const bf16x8*)(ap + k), b0 = *(const bf16x8*)(bp0 + k), b1 = *(const bf16x8*)(bp1 + k);
            acc[h][0] = __builtin_amdgcn_mfma_f32_32x32x16_bf16(a, b0, acc[h][0], 0, 0, 0);
            acc[h][1] = __builtin_amdgcn_mfma_f32_32x32x16_bf16(a, b1, acc[h][1], 0, 0, 0); } }
#pragma unroll
    for (int h = 0; h < NH; ++h)
#pragma unroll
        for (int ct = 0; ct < 2; ++ct)
#pragma unroll
            for (int r = 0; r < 16; ++r) red[(((h * 8 + c.wave) * 2 + ct) * 16 + r) * 64 + c.lane] = acc[h][ct][r];
    __syncthreads();
#pragma unroll
    for (int h = 0; h < NH; ++h)
#pragma unroll
        for (int j = 0; j < 4; ++j) { const int e = c.tid + 512 * j, row = e >> 6, col = e & 63, ct = col >> 5, l2 = (col & 31) + 32 * ((row >> 2) & 1), r = (row & 3) + 4 * (row >> 3);
            float s = 0.f;
#pragma unroll
            for (int w = 0; w < 8; ++w) s += red[(((h * 8 + w) * 2 + ct) * 16 + r) * 64 + l2];
            res[h][j] = s; }
    __syncthreads();
}
__device__ __forceinline__ void tail_branch(PP P, unsigned char* lds, const Ctx& c) {
    const bf16_t* Z1 = (const bf16_t*)(P->ws + WS_Z1); const bf16_t* Z4 = (const bf16_t*)(P->ws + WS_Z4); bf16_t* O = (bf16_t*)(P->ws + WS_Z0);
    for (int t = blockIdx.x; t < 256; t += gridDim.x) { const int row0 = MP + (t >> 4) * 32, col0 = (t & 15) * 64;
        float res[2][4];
        small_gemm_tile<2>(Z1, 2048, (const bf16_t*)(P->ws + WS_WBR), 2048, 1024, row0, col0, lds, c, res);
#pragma unroll
        for (int j = 0; j < 4; ++j) { const int e = c.tid + 512 * j, row = row0 + (e >> 6), col = col0 + (e & 63);
            const float gm = bf2f(Z4[(size_t)row * 2048 + col]), ga = bf2f(Z4[(size_t)row * 2048 + 1024 + col]);
            O[(size_t)row * 1024 + col] = (bf16_t)f2bf(gm * res[0][j] + ga * res[1][j]); } }
}
__device__ __forceinline__ void tail_res(PP P, unsigned char* lds, const Ctx& c, const bf16_t* A, int lda, const bf16_t* Bt, int K, int goff, const float* bias, int inplace) {
    const float* mod = (const float*)(P->ws + WS_MOD);
    for (int t = blockIdx.x; t < 256; t += gridDim.x) { const int row0 = MP + (t >> 4) * 32, col0 = (t & 15) * 64;
        float res[1][4];
        small_gemm_tile<1>(A, lda, Bt, K, K, row0, col0, lds, c, res);
#pragma unroll
        for (int j = 0; j < 4; ++j) { const int e = c.tid + 512 * j, row = row0 + (e >> 6), col = col0 + (e & 63);
            const float g = mod[(size_t)seq_of_row(row) * 6144 + goff + col];
            float a = res[0][j]; if (bias) a += bias[col];
            if (inplace) P->out[(size_t)row * 1024 + col] = ALPHA * bf2f(((const bf16_t*)(P->ws + WS_X1))[(size_t)row * 1024 + col]) + g * a;
            else ((bf16_t*)(P->ws + WS_XP))[(size_t)row * 1024 + col] = (bf16_t)f2bf(ALPHA * P->x_s[(size_t)(row - MP) * 1024 + col] + g * a); } }
}

__device__ __forceinline__ void fixup_rows(PP P, const Ctx& c, int pm) {
    const bf16_t* UB = (const bf16_t*)(P->ws + WS_UB); bf16_t* ACT = (bf16_t*)(P->ws + WS_ACT); const bool first = (pm & 31) == 0;
    for (int i = c.tid; i < 2 * DFF; i += 512) { const int rr = i >= DFF ? 1 : 0, f = i - rr * DFF;
        float av = P->conv_b[f], gv = P->conv_b[DFF + f];
#pragma unroll
        for (int j = 0; j < 3; ++j) { const int slot = rr + j; if (first && slot < 2) continue;
            av += P->conv_w[j * F2 + f] * bf2f(UB[((size_t)pm * 4 + slot) * F2 + f]); gv += P->conv_w[j * F2 + DFF + f] * bf2f(UB[((size_t)pm * 4 + slot) * F2 + DFF + f]); }
        ACT[(size_t)(pm * 256 + rr) * DFF + f] = (bf16_t)f2bf(gelu_tanh(av) * gv); }
}
__device__ __forceinline__ void pconv_out(PP P, const Ctx& c) {
    const bf16_t* UB = (const bf16_t*)(P->ws + WS_UB);
    for (int i = blockIdx.x * 512 + c.tid; i < 2 * 2 * F2; i += gridDim.x * 512) { const int col = i % F2, r = (i / F2) & 1, b = i / (2 * F2); P->out[O_PCONV + i] = bf2f(UB[((size_t)(32 * (b + 1)) * 4 + r) * F2 + col]); }
}

#define XB_TMO      128
#define XB_XCNT(j)  (256  + 64 * (j))
#define XB_XSUB(j)  (1280 + 64 * (j))
#define XB_XGEN(j)  (2304 + 64 * (j))
#define XB_TOP      3328
#define XB_TOPGEN   3392
#define XCD_BAR_WORDS 3456
#define XB_SPIN_CAP (1u << 22)
__device__ __forceinline__ unsigned xb_ld(unsigned* p)              { return __hip_atomic_load(p, __ATOMIC_RELAXED, __HIP_MEMORY_SCOPE_AGENT); }
__device__ __forceinline__ unsigned xb_add(unsigned* p, unsigned v) { return __hip_atomic_fetch_add(p, v, __ATOMIC_RELAXED, __HIP_MEMORY_SCOPE_AGENT); }
__device__ __forceinline__ unsigned xb_xcc_id() { return (unsigned)__builtin_amdgcn_s_getreg((3 << 11) | 20) & 0xFu; }
#define XB_SPIN(cond, bar) do { unsigned _sp = 0; while (cond) { __builtin_amdgcn_s_sleep(1); \
    if ((++_sp & 255u) == 0u) { if (xb_ld(&(bar)[XB_TMO])) break; if (_sp > XB_SPIN_CAP) { atomicAdd(&(bar)[XB_TMO], 1u); break; } } } } while (0)
struct XcdBarrier { unsigned* bar; unsigned x; volatile LAS unsigned* st; };
__device__ __forceinline__ XcdBarrier xcd_barrier_post(unsigned* bar, volatile LAS unsigned* st) {
    XcdBarrier b; b.bar = bar; b.x = xb_xcc_id(); b.st = st;
    if (threadIdx.x == 0) (void)xb_add(&bar[XB_XCNT(b.x)], 1u);
    return b;
}
__device__ __forceinline__ void xcd_barrier_complete(unsigned* bar, unsigned x, unsigned& nloc, unsigned& nx) {
    const unsigned G = gridDim.x * gridDim.y * gridDim.z;
    unsigned sum, cnt, mine, sp = 0u;
    for (;;) {
        sum = 0u; cnt = 0u; mine = 0u;
#pragma unroll
        for (unsigned j = 0; j < 16; ++j) { const unsigned c = xb_ld(&bar[XB_XCNT(j)]); sum += c; cnt += (c > 0u) ? 1u : 0u; mine = (j == x) ? c : mine; }
        if (sum == G) break;
        __builtin_amdgcn_s_sleep(1);
        if ((++sp & 255u) == 0u) { if (xb_ld(&bar[XB_TMO])) break; if (sp > XB_SPIN_CAP) { atomicAdd(&bar[XB_TMO], 1u); break; } }
    }
    nloc = mine > 0u ? mine : 1u; nx = cnt > 0u ? cnt : 1u;
}
__device__ __forceinline__ void xcd_barrier(const XcdBarrier& b) {
    asm volatile("s_waitcnt vmcnt(0)" ::: "memory");
    __syncthreads();
    if (threadIdx.x == 0) {
        unsigned* bar = b.bar;
        __builtin_amdgcn_s_waitcnt(0);
        unsigned nloc = b.st[0], nx = b.st[1];
        if (nloc == 0u) { xcd_barrier_complete(bar, b.x, nloc, nx); b.st[0] = nloc; b.st[1] = nx; }
        const unsigned old = xb_add(&bar[XB_XSUB(b.x)], 1u);
        const unsigned gen = old / nloc;
        if (old + 1u == (gen + 1u) * nloc) {
            __builtin_amdgcn_fence(__ATOMIC_RELEASE, "agent");
            asm volatile("s_waitcnt vmcnt(0)" ::: "memory");
            const unsigned og = xb_add(&bar[XB_TOP], 1u);
            const unsigned tg = og / nx;
            if (og + 1u == (tg + 1u) * nx) xb_add(&bar[XB_TOPGEN], 1u);
            else XB_SPIN(xb_ld(&bar[XB_TOPGEN]) == tg, bar);
            __builtin_amdgcn_fence(__ATOMIC_ACQUIRE, "agent");
            xb_add(&bar[XB_XGEN(b.x)], 1u);
            asm volatile("s_waitcnt vmcnt(0)" ::: "memory");
        } else {
            XB_SPIN(xb_ld(&bar[XB_XGEN(b.x)]) == gen, bar);
            __builtin_amdgcn_fence(__ATOMIC_ACQUIRE, "agent");
            asm volatile("s_waitcnt vmcnt(0)" ::: "memory");
        }
    }
    __syncthreads();
}

__global__ void __launch_bounds__(512, 2) fwd_megakernel(Params Pk) {
    extern __shared__ __attribute__((aligned(16))) unsigned char lds[];
    cg::grid_group grid = cg::this_grid();
    Ctx c;
#define MKCTX() do { int t_ = threadIdx.x; asm volatile("" : "+v"(t_)); c.tid = t_; c.lane = t_ & 63; c.wave = __builtin_amdgcn_readfirstlane(t_ >> 6); c.vw = c.wave * gridDim.x + blockIdx.x; c.nvw = 8 * gridDim.x; } while (0)
    MKCTX();
    LAS unsigned char* ldsl = (LAS unsigned char*)lds;
    const int G = gridDim.x, bid = blockIdx.x;
    PP P = (PP)__builtin_amdgcn_kernarg_segment_ptr();
    if (threadIdx.x < 2) ((volatile LAS unsigned*)(ldsl + LDS_BAR_OFF))[threadIdx.x] = 0u;
    __syncthreads();
    if (blockIdx.x == 0) { unsigned* zb = (unsigned*)(P->ws + WS_BAR); for (int i = threadIdx.x; i < 8192; i += 512) zb[i] = 0u; }
#define LAUNDER() asm volatile("" : "+s"(P))
#define HS ((bf16_t*)(P->out + O_SC))
#define HB ((bf16_t*)(P->ws + WS_Z0))

    if constexpr (PH_MASK & 1) phase0(P, lds, c);
    grid.sync(); LAUNDER(); MKCTX();
    XcdBarrier xbar = xcd_barrier_post((unsigned*)(P->ws + WS_BAR), (volatile LAS unsigned*)(ldsl + LDS_BAR_OFF));
    if constexpr (PH_MASK & 2) phase1(P, c, HS);
    xcd_barrier(xbar); LAUNDER(); MKCTX();
    if constexpr (PH_MASK & 4) { pg8::Gemm g{HS, (const bf16_t*)(P->ws + WS_W1T), MT, N1, 1024, 1024, 1024}; pg8::StaticOrder S; S.init(MT, N1, G, bid);
      EpiZ E{P->ws, (const float*)(P->ws + WS_MISC + MISC_BIASZ)}; pg8::gemm_phase<EpiZ>(ldsl, g, S, E);
      { const int nfull = (MT / 256) * (N1 / 256) % G; if (nfull != 0 && bid >= nfull) { MKCTX(); late_copies_a(P, lds, c, (bid - nfull) * 8 + c.wave, (G - nfull) * 8); }
        else if (nfull == 0) { MKCTX(); late_copies_a(P, lds, c, bid * 8 + c.wave, G * 8); } } }
    xcd_barrier(xbar); LAUNDER(); MKCTX();
    if constexpr (PH_MASK & 8) phase3(P, lds, c);
    xcd_barrier(xbar); LAUNDER(); MKCTX();
    if constexpr (PH_MASK & 16) phase4(P, lds, c);
    xcd_barrier(xbar); LAUNDER(); MKCTX();
    if constexpr (PH_MASK & 32) for (int u = bid; u < 512; u += G) mlstm_out_unit(P, lds, c, u);
    xcd_barrier(xbar); LAUNDER(); MKCTX();
    if constexpr (PH_MASK & 64) { pg8::Gemm g{(const bf16_t*)(P->ws + WS_Z1), (const bf16_t*)(P->ws + WS_WBR), MT, 1024, 2048, 2048, 2048}; pg8::StaticOrder S; S.init(MP, 1024, G, bid);
      EpiBranch E{(const bf16_t*)(P->ws + WS_Z4), HB}; pg8::gemm_phase<EpiBranch>(ldsl, g, S, E); MKCTX(); tail_branch(P, lds, c); }
    xcd_barrier(xbar); LAUNDER(); MKCTX();
    if constexpr (PH_MASK & 128) { pg8::Gemm g{HB, (const bf16_t*)(P->ws + WS_WOT), MT, 1024, 1024, 1024, 1024}; pg8::StaticOrder S; S.init(MP, 1024, G, bid);
      EpiRes E{P->x_p, P->x_s, (const float*)(P->ws + WS_MOD), 2048, (bf16_t*)(P->ws + WS_XP)}; pg8::gemm_phase<EpiRes>(ldsl, g, S, E); MKCTX();
      tail_res(P, lds, c, HB, 1024, (const bf16_t*)(P->ws + WS_WOT), 1024, 2048, nullptr, 0); }
    xcd_barrier(xbar); LAUNDER(); MKCTX();
    if constexpr (PH_MASK & 256) phase8(P, c, HB);
    xcd_barrier(xbar); LAUNDER(); MKCTX();
    if constexpr (PH_MASK & 512) { pg8::Gemm g{HB, (const bf16_t*)(P->ws + WS_WUT), MT, F2, 1024, 1024, 1024}; pg8::StaticOrder S; S.init(MT, F2, G, bid);
      EpiUp E{P->b_up, P->conv_w, P->conv_b, (bf16_t*)(P->ws + WS_SCR) + (size_t)bid * 65536, (bf16_t*)(P->ws + WS_UB), (bf16_t*)(P->ws + WS_US), (bf16_t*)(P->ws + WS_ACT), P->st_conv, P->out + O_SCONV};
      pg8::gemm_phase<EpiUp>(ldsl, g, S, E);
      { const int nfull = (MT / 256) * (F2 / 256) % G; if (nfull != 0 && bid >= nfull) { MKCTX(); late_copies_b(P, lds, c, (bid - nfull) * 8 + c.wave, (G - nfull) * 8); }
        else if (nfull == 0) { MKCTX(); late_copies_b(P, lds, c, bid * 8 + c.wave, G * 8); } } }
    xcd_barrier(xbar); LAUNDER(); MKCTX();
    if constexpr (PH_MASK & 2048) { pg8::Gemm g{(const bf16_t*)(P->ws + WS_ACT), (const bf16_t*)(P->ws + WS_WDT), MT, 1024, DFF, DFF, DFF}; pg8::StaticOrder S; S.init(MP, 1024, G, bid);
      { pg8::Unit u0; if (S.next(0, u0)) fixup_rows(P, c, u0.pm); asm volatile("s_waitcnt vmcnt(0)" ::: "memory"); __syncthreads(); }
      EpiDownLn E{(const float*)(P->ws + WS_MOD), P->b_down, P->ln2g, P->ln2b, P->out, (const bf16_t*)(P->ws + WS_X1), (unsigned long long*)(P->ws + WS_XBUF), (unsigned*)(P->ws + WS_CNT)}; pg8::gemm_phase<EpiDownLn>(ldsl, g, S, E); MKCTX();
      tail_res(P, lds, c, (const bf16_t*)(P->ws + WS_ACT), DFF, (const bf16_t*)(P->ws + WS_WDT), DFF, 5120, P->b_down, 1); }
    xcd_barrier(xbar); LAUNDER(); MKCTX();
    if constexpr (PH_MASK & 4096) { phase12(P, c); pconv_out(P, c); }
}
#undef LAUNDER
#undef MKCTX
#undef HS
#undef HB

extern "C" void kernel_launch(void* const* d_in, const int* in_sizes, int n_in, void* d_out, int out_size, void* d_ws, size_t ws_size, hipStream_t stream) {
    static int grid_blocks = 0;
    if (grid_blocks == 0) {
        int dev = 0, cus = 0, per_cu = 0;
        hipGetDevice(&dev);
        hipDeviceGetAttribute(&cus, hipDeviceAttributeMultiprocessorCount, dev);
        hipFuncSetAttribute((const void*)fwd_megakernel, hipFuncAttributeMaxDynamicSharedMemorySize, LDS_BYTES);
        hipOccupancyMaxActiveBlocksPerMultiprocessor(&per_cu, (const void*)fwd_megakernel, 512, LDS_BYTES);
        if (per_cu < 1) { fprintf(stderr, "occupancy query reports %d blocks/CU\n", per_cu); per_cu = 1; }
        if (per_cu > 1) per_cu = 1;
        grid_blocks = cus * per_cu;
        if (grid_blocks > 256) grid_blocks = 256;
        if (n_in != 29 || ws_size < 256 * MiB) fprintf(stderr, "kernel_launch: unexpected n_in %d / ws_size %zu\n", n_in, ws_size);
    }
    Params p{};
    const float** pp = (const float**)&p;
    for (int i = 0; i < 29; ++i) pp[i] = (const float*)d_in[i];
    p.out = (float*)d_out; p.ws = (unsigned char*)d_ws;
    void* args[] = {&p};
    hipError_t e = hipLaunchCooperativeKernel((const void*)fwd_megakernel, dim3(grid_blocks), dim3(512), args, LDS_BYTES, stream);
    if (e != hipSuccess) fprintf(stderr, "cooperative launch failed: %s (grid %d)\n", hipGetErrorString(e), grid_blocks);
}
```

```cpp
#include <hip/hip_runtime.h>
#include <hip/hip_cooperative_groups.h>
#include <cstdio>
#include <cstdint>
namespace cg = cooperative_groups;

typedef unsigned short bf16_t;
typedef short bf16x8 __attribute__((ext_vector_type(8)));
typedef float f32x4 __attribute__((ext_vector_type(4)));
typedef float f32x2 __attribute__((ext_vector_type(2)));
typedef float f32x16 __attribute__((ext_vector_type(16)));
typedef unsigned u32x4 __attribute__((ext_vector_type(4)));
typedef unsigned u32x2 __attribute__((ext_vector_type(2)));
#define LAS __attribute__((address_space(3)))

constexpr int D = 1024, SEQ = 8192, MP = 16384, MS = 512, MT = 16896, NSEQ = 130;
constexpr int N1 = 6656, DIN = 6664, F2 = 5632, DFF = 2816;
constexpr float LN_EPS = 1e-5f;
constexpr float ALPHA = 1.189207115002721f;
constexpr size_t O_Y = 0, O_PC = 17301504, O_PN = 17563648, O_PM = 17564672, O_PK = 17564680, O_PV = 17630216, O_PCONV = 17695752,
                 O_SC = 17718280, O_SN = 34495496, O_SM = 34561032, O_SK = 34561544, O_SV = 38755848, O_SCONV = 42950152;
constexpr size_t MiB = 1u << 20;
constexpr size_t WS_W1T = 0;
constexpr size_t WS_UB = 0;
constexpr size_t WS_US = 4 * MiB;
constexpr size_t WS_WBR = 13 * MiB;
constexpr size_t WS_WOT = 17 * MiB;
constexpr size_t WS_WUT = 19 * MiB;
constexpr size_t WS_WDT = 30 * MiB;
constexpr size_t WS_MOD = 35 * MiB + 512 * 1024;
constexpr size_t WS_GATES = 38 * MiB + 640 * 1024;
constexpr size_t WS_MISC = 39 * MiB + 256 * 1024;
static_assert(WS_MOD + 130 * 6144 * 4 <= WS_GATES && WS_GATES + 16896 * 8 * 4 <= WS_MISC && WS_MISC + 81920 + 8 * 64 * 128 * 4 <= 40 * MiB, "ws map");
constexpr size_t MISC_WG = 0;
constexpr size_t MISC_BIASZ = 32768;
constexpr size_t MISC_CH = 65536;
constexpr size_t MISC_MC = 65536 + 4096;
constexpr size_t MISC_UN = 81920;
constexpr size_t WS_Z0 = 40 * MiB;
constexpr size_t WS_Z1 = 73 * MiB;
constexpr size_t WS_Z2 = 139 * MiB;
constexpr size_t WS_Z3 = 155 * MiB + 512 * 1024;
constexpr size_t WS_Z4 = 188 * MiB + 512 * 1024;
constexpr size_t WS_XP = 73 * MiB;
constexpr size_t WS_X1 = 200 * MiB;
constexpr size_t WS_ACT = 73 * MiB;
constexpr size_t WS_SCR = 164 * MiB;
constexpr size_t WS_BAR = 39 * MiB + 640 * 1024;
constexpr size_t WS_CNT = WS_BAR + 16384;
constexpr size_t WS_XBUF = 254 * MiB + 512 * 1024;
constexpr int LDS_BAR_OFF = 147456 - 256;
constexpr int LDS_BYTES = 147456;
#ifndef PH_MASK
#define PH_MASK 0x1FFF
#endif

__device__ __forceinline__ float bf2f(bf16_t b) { return __uint_as_float(((unsigned)b) << 16); }
typedef __bf16 bf16x2_t __attribute__((ext_vector_type(2)));
__device__ __forceinline__ unsigned pk2(float lo, float hi) { const f32x2 v = {lo, hi}; const bf16x2_t b = __builtin_convertvector(v, bf16x2_t); return __builtin_bit_cast(unsigned, b); }
__device__ __forceinline__ unsigned f2bf(float f) { return pk2(f, 0.f) & 0xffffu; }
__device__ __forceinline__ float lo16(unsigned w) { return __uint_as_float(w << 16); }
__device__ __forceinline__ float hi16(unsigned w) { return __uint_as_float(w & 0xffff0000u); }
__device__ __forceinline__ float sigmoidf_(float x) { return __builtin_amdgcn_rcpf(1.f + __expf(-x)); }
__device__ __forceinline__ float wave_sum(float v) {
#pragma unroll
    for (int o = 1; o < 64; o <<= 1) v += __shfl_xor(v, o);
    return v;
}
__device__ __forceinline__ float wave_max(float v) {
#pragma unroll
    for (int o = 1; o < 64; o <<= 1) v = fmaxf(v, __shfl_xor(v, o));
    return v;
}
__device__ __forceinline__ float gelu_tanh(float x) { const float y = 0.7978845608028654f * (x + 0.044715f * x * x * x); return x * sigmoidf_(2.f * y); }

namespace pg8 {
constexpr int BM = 256, BK = 64, HALF = 128, HTB = HALF * BK * 2, STAGE_BYTES = 8 * HTB, NXCD = 8, WGM = 8;
__host__ __device__ __forceinline__ int lds_byte(int r, int c) { const int st = (r >> 4) * 2 + (c >> 5), rr = r & 15, cc = c & 31, ob = rr * 64 + cc * 2; return st * 1024 + (ob ^ (((ob >> 9) & 1) << 5)); }
__host__ __device__ __forceinline__ void stage_rc(int b, int& R, int& C) { const int st = b / 1024, sb = b % 1024, swz = sb ^ (((sb >> 9) & 1) << 5); R = (st >> 1) * 16 + swz / 64; C = (st & 1) * 32 + (swz % 64) / 2; }
__host__ __device__ __forceinline__ int perm32(int rho) { const int n = rho >> 4, i = rho & 15; return 8 * (i >> 2) + 4 * n + (i & 3); }
struct Unit { int pm, pn; };
struct Gemm { const bf16_t* A; const bf16_t* Bt; int M, N, K, lda, ldb; };
struct StaticOrder {
    int nM, nN, nwg, G, c;
    __host__ __device__ __forceinline__ void init(int M, int N, int G_, int c_) { nM = M / BM; nN = N / BM; nwg = nM * nN; G = G_; c = c_; }
    __host__ __device__ __forceinline__ bool next(int i, Unit& u) const {
        const long L = (long)i * G + c; if (L >= nwg) return false;
        int wgid = (int)L; { const int q = nwg / NXCD, r = nwg % NXCD, xcd = wgid % NXCD, off = wgid / NXCD; wgid = (xcd < r ? xcd * (q + 1) : r * (q + 1) + (xcd - r) * q) + off; }
        const int nig = WGM * nN, gid = wgid / nig, fm = gid * WGM, gsz = (nM - fm) < WGM ? (nM - fm) : WGM;
        u.pm = fm + ((wgid % nig) % gsz); u.pn = (wgid % nig) / gsz; return true;
    }
};
template <class Epi>
__device__ __forceinline__ void gemm_phase(LAS unsigned char* lds, const Gemm g, const StaticOrder& S, const Epi& E) {
    int tid_ = threadIdx.x; asm volatile("" : "+v"(tid_));
    const int tid = tid_, wid = __builtin_amdgcn_readfirstlane(tid >> 6), lane = tid & 63, wr = wid >> 2, wc = wid & 3, fr = lane & 15, fq = lane >> 4;
    const int K = g.K, nt = K / BK;
    unsigned voffA[2], voffB[2];
#pragma unroll
    for (int i = 0; i < 2; ++i) { int R, C; stage_rc(tid * 16 + i * 8192, R, C); const int Rb = Epi::PERM ? ((R & ~31) + perm32(R & 31)) : R;
        voffA[i] = (unsigned)(R * g.lda + C) * 2u; voffB[i] = (unsigned)(Rb * g.ldb + C) * 2u; }
    const size_t kstep = (size_t)(BK * 2);
    const size_t hA = (size_t)HALF * g.lda * 2, hB = (size_t)HALF * g.ldb * 2;
    const size_t tA = 2 * hA, tB = 2 * hB;
    const unsigned ldsw = (unsigned)wid * 1024u;
    const int aoff = lds_byte(wr * 64 + fr, fq * 8), boff = lds_byte(wc * 32 + fr, fq * 8);
#define PG8_SA(b, h) (((b) * 2 + (h)) * HTB)
#define PG8_SB(b, h) ((4 + (b) * 2 + (h)) * HTB)
#define PG8_STAGE(bufoff, gbase, voff) do { _Pragma("unroll") for (int _i = 0; _i < 2; ++_i) \
        __builtin_amdgcn_global_load_lds((const unsigned*)((const char*)(gbase) + (voff)[_i]), (LAS unsigned*)(lds + (bufoff) + ldsw + _i * 8192), 16, 0, 0); } while (0)
#define PG8_LDA(dst, b, h) do { _Pragma("unroll") for (int m = 0; m < 4; ++m) _Pragma("unroll") for (int k = 0; k < 2; ++k) dst[m][k] = *(const LAS bf16x8*)(lds + PG8_SA(b, h) + aoff + m * 2048 + k * 1024); } while (0)
#define PG8_LDB(dst, b, h) do { _Pragma("unroll") for (int n = 0; n < 2; ++n) _Pragma("unroll") for (int k = 0; k < 2; ++k) dst[n][k] = *(const LAS bf16x8*)(lds + PG8_SB(b, h) + boff + n * 2048 + k * 1024); } while (0)
#define PG8_MMA(ai, bj, At, Bt) do { __builtin_amdgcn_s_setprio(1); _Pragma("unroll") for (int m = 0; m < 4; ++m) _Pragma("unroll") for (int n = 0; n < 2; ++n) _Pragma("unroll") for (int k = 0; k < 2; ++k) \
        acc[ai][bj][m][n] = __builtin_amdgcn_mfma_f32_16x16x32_bf16(Bt[n][k], At[m][k], acc[ai][bj][m][n], 0, 0, 0); __builtin_amdgcn_s_setprio(0); } while (0)
#define PG8_WAIT_V(n) asm volatile("s_waitcnt vmcnt(" #n ")" ::: "memory")
#define PG8_WAIT_L(n) asm volatile("s_waitcnt lgkmcnt(" #n ")" ::: "memory")
#define PG8_BAR __builtin_amdgcn_s_barrier()
#define PG8_SCHED __builtin_amdgcn_sched_barrier(0)
    Unit cur, nxt; int ui = 0;
    if (!S.next(0, cur)) return;
    f32x4 acc[2][2][4][2];
#pragma unroll
    for (int a = 0; a < 2; ++a)
#pragma unroll
        for (int b = 0; b < 2; ++b)
#pragma unroll
            for (int m = 0; m < 4; ++m)
#pragma unroll
                for (int n = 0; n < 2; ++n) acc[a][b][m][n] = (f32x4){0.f, 0.f, 0.f, 0.f};
    bf16x8 At[4][2], B0[2][2], B1[2][2];
    const char* cA = (const char*)g.A + (size_t)cur.pm * tA; const char* cB = (const char*)g.Bt + (size_t)cur.pn * tB;
    PG8_STAGE(PG8_SB(0, 0), cB, voffB); PG8_STAGE(PG8_SB(0, 1), cB + hB, voffB); PG8_STAGE(PG8_SA(0, 0), cA, voffA); PG8_STAGE(PG8_SA(0, 1), cA + hA, voffA);
    if (wr == 1) PG8_BAR;
    PG8_WAIT_V(2); PG8_BAR;
    PG8_STAGE(PG8_SB(1, 0), cB + kstep, voffB); PG8_STAGE(PG8_SA(1, 0), cA + kstep, voffA); PG8_STAGE(PG8_SB(1, 1), cB + hB + kstep, voffB);
    PG8_WAIT_V(6); PG8_BAR;
    for (;;) {
        const bool has_next = S.next(ui + 1, nxt);
        const char* nA = has_next ? (const char*)g.A + (size_t)nxt.pm * tA : cA; const char* nB = has_next ? (const char*)g.Bt + (size_t)nxt.pn * tB : cB;
        for (int t = 0; t < nt; t += 2) {
            const bool last = (t == nt - 2);
            const char* a1 = cA + (size_t)(t + 1) * kstep;
            const char* a2 = last ? nA : cA + (size_t)(t + 2) * kstep; const char* b2 = last ? nB : cB + (size_t)(t + 2) * kstep;
            const char* a3 = a2 + kstep; const char* b3 = b2 + kstep;
            if constexpr (Epi::HAS_MID) { if (t == nt / 2) E.mid(acc, cur, wr, wc, fr, fq); }
            PG8_LDB(B0, 0, 0); PG8_LDB(B1, 0, 1); PG8_SCHED; PG8_LDA(At, 0, 0); PG8_STAGE(PG8_SA(1, 1), a1 + hA, voffA);
            PG8_WAIT_V(8); PG8_WAIT_L(0); PG8_BAR; PG8_MMA(0, 0, At, B0); PG8_MMA(0, 1, At, B1); PG8_BAR; PG8_SCHED;
            PG8_LDA(At, 0, 1); PG8_STAGE(PG8_SB(0, 0), b2, voffB); PG8_STAGE(PG8_SB(0, 1), b2 + hB, voffB); PG8_STAGE(PG8_SA(0, 0), a2, voffA);
            PG8_WAIT_V(8); PG8_WAIT_L(0); PG8_BAR; PG8_MMA(1, 0, At, B0); PG8_MMA(1, 1, At, B1); PG8_BAR; PG8_SCHED;
            PG8_LDB(B0, 1, 0); PG8_LDB(B1, 1, 1); PG8_SCHED; PG8_LDA(At, 1, 0); PG8_STAGE(PG8_SA(0, 1), a2 + hA, voffA);
            PG8_WAIT_V(8); PG8_WAIT_L(0); PG8_BAR; PG8_MMA(0, 0, At, B0); PG8_MMA(0, 1, At, B1); PG8_BAR; PG8_SCHED;
            PG8_LDA(At, 1, 1); PG8_STAGE(PG8_SB(1, 0), b3, voffB); PG8_STAGE(PG8_SB(1, 1), b3 + hB, voffB); PG8_STAGE(PG8_SA(1, 0), a3, voffA);
            PG8_WAIT_V(8); PG8_WAIT_L(0); PG8_BAR; PG8_MMA(1, 0, At, B0); PG8_MMA(1, 1, At, B1); PG8_BAR; PG8_SCHED;
        }
        if (wr == 0) PG8_BAR;
        if constexpr (!Epi::AFTER_DRAIN) E(acc, cur, wr, wc, fr, fq);
        if (!has_next) break;
#pragma unroll
        for (int a = 0; a < 2; ++a)
#pragma unroll
            for (int b = 0; b < 2; ++b)
#pragma unroll
                for (int m = 0; m < 4; ++m)
#pragma unroll
                    for (int n = 0; n < 2; ++n) acc[a][b][m][n] = (f32x4){0.f, 0.f, 0.f, 0.f};
        cur = nxt; cA = nA; cB = nB; ++ui;
        if (wr == 1) PG8_BAR;
    }
    PG8_WAIT_V(0);
    PG8_BAR;
    if constexpr (Epi::AFTER_DRAIN) E.fused(acc, cur, lds);
#undef PG8_SA
#undef PG8_SB
#undef PG8_STAGE
#undef PG8_LDA
#undef PG8_LDB
#undef PG8_MMA
#undef PG8_WAIT_V
#undef PG8_WAIT_L
#undef PG8_BAR
#undef PG8_SCHED
}
}

typedef f32x4 Acc[2][2][4][2];

struct Params {
    const float *x_p, *x_s, *c_p, *c_s, *st_C, *st_n, *st_m, *ck, *cv, *st_conv;
    const float *w_ada, *b_ada, *w_in, *b_in, *mnorm, *sinks, *w_bm, *w_ba, *w_out, *ln1g, *ln1b, *w_up, *b_up, *conv_w, *conv_b, *w_down, *b_down, *ln2g, *ln2b;
    float* out; unsigned char* ws;
};

typedef const __attribute__((address_space(4))) Params* PP;
__device__ __forceinline__ int seq_of_row(int row) { return row < MP ? (row >> 13) : 2 + ((row - MP) >> 2); }

struct EpiZ {
    static constexpr bool PERM = true, HAS_MID = false, AFTER_DRAIN = false;
    unsigned char* ws; const float* biasz;
    __device__ __forceinline__ void operator()(const Acc& acc, const pg8::Unit& u, int wr, int wc, int fr, int fq) const {
        { int tv_ = threadIdx.x; asm volatile("" : "+v"(tv_)); fr = tv_ & 15; fq = (tv_ >> 4) & 3; wc = (tv_ >> 6) & 3; wr = tv_ >> 8; }
        const int pn = u.pn; size_t slab; int ldc, cb; float sc = 1.f;
        if (pn < 4) { slab = WS_Z0; ldc = 1024; cb = pn * 256; if (pn < 2) sc = 0.08838834764831845f; }
        else if (pn < 12) { slab = WS_Z1; ldc = 2048; cb = (pn - 4) * 256; if (pn >= 8) sc = 0.125f; }
        else if (pn < 14) { slab = WS_Z2; ldc = 512; cb = (pn - 12) * 256; }
        else if (pn < 18) { slab = WS_Z3; ldc = 1024; cb = (pn - 14) * 256; }
        else { slab = WS_Z4; ldc = 2048; cb = (pn - 18) * 256; }
        bf16_t* base = (bf16_t*)(ws + slab);
        const int row0 = u.pm * 256 + wr * 64 + fr, col0 = cb + wc * 32 + 8 * fq, bcol0 = pn * 256 + wc * 32 + 8 * fq;
        f32x4 bv[2][2];
#pragma unroll
        for (int bj = 0; bj < 2; ++bj)
#pragma unroll
            for (int n = 0; n < 2; ++n) bv[bj][n] = *(const f32x4*)(biasz + bcol0 + bj * 128 + 4 * n);
#pragma unroll
        for (int ai = 0; ai < 2; ++ai)
#pragma unroll
            for (int m = 0; m < 4; ++m) { bf16_t* rowp = base + (size_t)(row0 + ai * 128 + m * 16) * ldc + col0;
#pragma unroll
                for (int bj = 0; bj < 2; ++bj) { f32x4 v0 = (acc[ai][bj][m][0] + bv[bj][0]) * sc, v1 = (acc[ai][bj][m][1] + bv[bj][1]) * sc;
                    if (pn >= 14) { v0 = (f32x4){sigmoidf_(v0[0]), sigmoidf_(v0[1]), sigmoidf_(v0[2]), sigmoidf_(v0[3])}; v1 = (f32x4){sigmoidf_(v1[0]), sigmoidf_(v1[1]), sigmoidf_(v1[2]), sigmoidf_(v1[3])}; }
                    u32x4 w; w.x = pk2(v0[0], v0[1]); w.y = pk2(v0[2], v0[3]); w.z = pk2(v1[0], v1[1]); w.w = pk2(v1[2], v1[3]);
                    *(u32x4*)(rowp + bj * 128) = w; } }
    }
};

struct EpiBranch {
    static constexpr bool PERM = true, HAS_MID = true, AFTER_DRAIN = false;
    const bf16_t* Z4; bf16_t* O;
    __device__ __forceinline__ void mid(Acc& acc, const pg8::Unit& u, int wr, int wc, int fr, int fq) const {
        { int tv_ = threadIdx.x; asm volatile("" : "+v"(tv_)); fr = tv_ & 15; fq = (tv_ >> 4) & 3; wc = (tv_ >> 6) & 3; wr = tv_ >> 8; }
        const int row0 = u.pm * 256 + wr * 64 + fr, col0 = u.pn * 256 + wc * 32 + 8 * fq;
#pragma unroll
        for (int ai = 0; ai < 2; ++ai)
#pragma unroll
            for (int m = 0; m < 4; ++m) { const bf16_t* rp = Z4 + (size_t)(row0 + ai * 128 + m * 16) * 2048 + col0;
#pragma unroll
                for (int bj = 0; bj < 2; ++bj) { const u32x4 gm = *(const u32x4*)(rp + bj * 128), ga = *(const u32x4*)(rp + 1024 + bj * 128);
#pragma unroll
                    for (int q = 0; q < 4; ++q) { const float m0 = lo16(gm[q]), m1 = hi16(gm[q]), a0 = lo16(ga[q]), a1 = hi16(ga[q]);
                        const float r0 = m0 * __builtin_amdgcn_rcpf(a0), r1 = m1 * __builtin_amdgcn_rcpf(a1);
                        acc[ai][bj][m][q >> 1][(q & 1) * 2] *= r0; acc[ai][bj][m][q >> 1][(q & 1) * 2 + 1] *= r1; } } }
    }
    __device__ __forceinline__ void operator()(const Acc& acc, const pg8::Unit& u, int wr, int wc, int fr, int fq) const {
        { int tv_ = threadIdx.x; asm volatile("" : "+v"(tv_)); fr = tv_ & 15; fq = (tv_ >> 4) & 3; wc = (tv_ >> 6) & 3; wr = tv_ >> 8; }
        const int row0 = u.pm * 256 + wr * 64 + fr, col0 = u.pn * 256 + wc * 32 + 8 * fq;
#pragma unroll
        for (int ai = 0; ai < 2; ++ai)
#pragma unroll
            for (int m = 0; m < 4; ++m) { const size_t r = (size_t)(row0 + ai * 128 + m * 16);
#pragma unroll
                for (int bj = 0; bj < 2; ++bj) { const u32x4 ga = *(const u32x4*)(Z4 + r * 2048 + 1024 + col0 + bj * 128);
                    float v[8];
#pragma unroll
                    for (int q = 0; q < 4; ++q) { v[2 * q] = acc[ai][bj][m][q >> 1][(q & 1) * 2] * lo16(ga[q]); v[2 * q + 1] = acc[ai][bj][m][q >> 1][(q & 1) * 2 + 1] * hi16(ga[q]); }
                    u32x4 w; w.x = pk2(v[0], v[1]); w.y = pk2(v[2], v[3]); w.z = pk2(v[4], v[5]); w.w = pk2(v[6], v[7]);
                    *(u32x4*)(O + r * 1024 + col0 + bj * 128) = w; } }
    }
};

struct EpiRes {
    static constexpr bool PERM = false, HAS_MID = false, AFTER_DRAIN = false;
    const float *xp, *xs; const float* mod; int goff; bf16_t* obf;
    __device__ __forceinline__ void operator()(const Acc& acc, const pg8::Unit& u, int wr, int wc, int fr, int fq) const {
        { int tv_ = threadIdx.x; asm volatile("" : "+v"(tv_)); fr = tv_ & 15; fq = (tv_ >> 4) & 3; wc = (tv_ >> 6) & 3; wr = tv_ >> 8; }
        const int col0 = u.pn * 256 + wc * 32 + 4 * fq;
        const float* g = mod + (size_t)seq_of_row(u.pm * 256) * 6144 + goff;
        f32x4 gvv[2][2];
#pragma unroll
        for (int bj = 0; bj < 2; ++bj)
#pragma unroll
            for (int n = 0; n < 2; ++n) gvv[bj][n] = *(const f32x4*)(g + col0 + bj * 128 + n * 16);
#pragma unroll
        for (int ai = 0; ai < 2; ++ai)
#pragma unroll
            for (int m = 0; m < 4; ++m) { const int row = u.pm * 256 + ai * 128 + wr * 64 + m * 16 + fr;
                const float* bp = row < MP ? xp + (size_t)row * 1024 : xs + (size_t)(row - MP) * 1024;
#pragma unroll
                for (int bj = 0; bj < 2; ++bj)
#pragma unroll
                    for (int n = 0; n < 2; ++n) { const int c = col0 + bj * 128 + n * 16; const f32x4 gv = gvv[bj][n], xv = *(const f32x4*)(bp + c);
                        const f32x4 o = xv * ALPHA + gv * acc[ai][bj][m][n]; u32x2 w; w.x = pk2(o[0], o[1]); w.y = pk2(o[2], o[3]);
                        *(u32x2*)(obf + (size_t)row * 1024 + c) = w; } }
    }
};

struct EpiUp {
    static constexpr bool PERM = true, HAS_MID = false, AFTER_DRAIN = false;
    const float *b_up, *conv_w, *conv_b; bf16_t *scr, *UB, *US, *ACT; const float* st_conv; float* s_conv;
    __device__ __forceinline__ void operator()(const Acc& acc, const pg8::Unit& u, int wr, int wc, int fr, int fq) const {
        { int tv_ = threadIdx.x; asm volatile("" : "+v"(tv_)); fr = tv_ & 15; fq = (tv_ >> 4) & 3; wc = (tv_ >> 6) & 3; wr = tv_ >> 8; }
        const int pn = u.pn, pm = u.pm;
        const int cl0 = wc * 32 + 8 * fq;
        f32x4 bv[2][2];
#pragma unroll
        for (int bj = 0; bj < 2; ++bj)
#pragma unroll
            for (int n = 0; n < 2; ++n) bv[bj][n] = *(const f32x4*)(b_up + bj * DFF + pn * 128 + cl0 + 4 * n);
#pragma unroll
        for (int ai = 0; ai < 2; ++ai)
#pragma unroll
            for (int m = 0; m < 4; ++m) { const int rt = ai * 128 + wr * 64 + m * 16 + fr;
#pragma unroll
                for (int bj = 0; bj < 2; ++bj) { const f32x4 v0 = acc[ai][bj][m][0] + bv[bj][0], v1 = acc[ai][bj][m][1] + bv[bj][1];
                    u32x4 w; w.x = pk2(v0[0], v0[1]); w.y = pk2(v0[2], v0[3]); w.z = pk2(v1[0], v1[1]); w.w = pk2(v1[2], v1[3]);
                    *(u32x4*)(scr + rt * 256 + bj * 128 + cl0) = w; }
                __builtin_amdgcn_sched_barrier(0); }
        asm volatile("s_waitcnt vmcnt(0)" ::: "memory"); __builtin_amdgcn_s_barrier(); asm volatile("" ::: "memory");
        const int tid = threadIdx.x;
#define SCR_LD(p) __hip_atomic_load((const unsigned*)(p), __ATOMIC_RELAXED, __HIP_MEMORY_SCOPE_AGENT)
        if (pm >= 64) {
            const int f0 = (tid & 63) * 2, ca = pn * 128 + f0;
            const f32x2 cba = *(const f32x2*)(conv_b + ca), cbg = *(const f32x2*)(conv_b + DFF + ca);
            const f32x2 wa0 = *(const f32x2*)(conv_w + ca), wa1 = *(const f32x2*)(conv_w + F2 + ca), wa2 = *(const f32x2*)(conv_w + 2 * F2 + ca);
            const f32x2 wg0 = *(const f32x2*)(conv_w + DFF + ca), wg1 = *(const f32x2*)(conv_w + F2 + DFF + ca), wg2 = *(const f32x2*)(conv_w + 2 * F2 + DFF + ca);
#pragma unroll 1
            for (int hb = 0; hb < 2; ++hb) { const int r0 = (tid >> 6) * 32 + 16 * hb;
                unsigned ua[16], ug[16];
#pragma unroll
                for (int i = 0; i < 16; ++i) { ua[i] = SCR_LD(scr + (r0 + i) * 256 + f0); ug[i] = SCR_LD(scr + (r0 + i) * 256 + 128 + f0); }
#pragma unroll
                for (int sq4 = 0; sq4 < 4; ++sq4) { const int srow0 = (pm - 64) * 256 + r0 + 4 * sq4, bq = srow0 >> 2;
                    const f32x2 c0a = *(const f32x2*)(st_conv + ((size_t)bq * 2 + 0) * F2 + ca), c1a = *(const f32x2*)(st_conv + ((size_t)bq * 2 + 1) * F2 + ca);
                    const f32x2 c0g = *(const f32x2*)(st_conv + ((size_t)bq * 2 + 0) * F2 + DFF + ca), c1g = *(const f32x2*)(st_conv + ((size_t)bq * 2 + 1) * F2 + DFF + ca);
#pragma unroll
                    for (int t = 0; t < 4; ++t) { const int it = 4 * sq4 + t;
                        const f32x2 xa2 = (f32x2){lo16(ua[it]), hi16(ua[it])}, xg2 = (f32x2){lo16(ug[it]), hi16(ug[it])};
                        const f32x2 xa1 = t >= 1 ? (f32x2){lo16(ua[it - (t >= 1 ? 1 : 0)]), hi16(ua[it - (t >= 1 ? 1 : 0)])} : c1a, xg1 = t >= 1 ? (f32x2){lo16(ug[it - (t >= 1 ? 1 : 0)]), hi16(ug[it - (t >= 1 ? 1 : 0)])} : c1g;
                        const f32x2 xa0 = t >= 2 ? (f32x2){lo16(ua[it - (t >= 2 ? 2 : 0)]), hi16(ua[it - (t >= 2 ? 2 : 0)])} : (t == 0 ? c0a : c1a), xg0 = t >= 2 ? (f32x2){lo16(ug[it - (t >= 2 ? 2 : 0)]), hi16(ug[it - (t >= 2 ? 2 : 0)])} : (t == 0 ? c0g : c1g);
                        const float av0 = cba[0] + wa0[0] * xa0[0] + wa1[0] * xa1[0] + wa2[0] * xa2[0], av1 = cba[1] + wa0[1] * xa0[1] + wa1[1] * xa1[1] + wa2[1] * xa2[1];
                        const float gv0 = cbg[0] + wg0[0] * xg0[0] + wg1[0] * xg1[0] + wg2[0] * xg2[0], gv1 = cbg[1] + wg0[1] * xg0[1] + wg1[1] * xg1[1] + wg2[1] * xg2[1];
                        *(unsigned*)(ACT + (size_t)(MP + srow0 + t) * DFF + ca) = pk2(gelu_tanh(av0) * gv0, gelu_tanh(av1) * gv1);
                        if (t >= 2) { *(f32x2*)(s_conv + ((size_t)bq * 2 + (t - 2)) * F2 + ca) = xa2; *(f32x2*)(s_conv + ((size_t)bq * 2 + (t - 2)) * F2 + DFF + ca) = xg2; } } } }
        } else
        {
            const int f0 = (tid & 63) * 2, ca = pn * 128 + f0;
            const f32x2 cba = *(const f32x2*)(conv_b + ca), cbg = *(const f32x2*)(conv_b + DFF + ca);
            const f32x2 wa0 = *(const f32x2*)(conv_w + ca), wa1 = *(const f32x2*)(conv_w + F2 + ca), wa2 = *(const f32x2*)(conv_w + 2 * F2 + ca);
            const f32x2 wg0 = *(const f32x2*)(conv_w + DFF + ca), wg1 = *(const f32x2*)(conv_w + F2 + DFF + ca), wg2 = *(const f32x2*)(conv_w + 2 * F2 + DFF + ca);
#pragma unroll 1
            for (int hb = 0; hb < 2; ++hb) { const int r0 = (tid >> 6) * 32 + 16 * hb;
            unsigned ua[18], ug[18];
#pragma unroll
            for (int i = 0; i < 18; ++i) { int r = r0 - 2 + i; r = r < 0 ? 0 : r; ua[i] = SCR_LD(scr + r * 256 + f0); ug[i] = SCR_LD(scr + r * 256 + 128 + f0); }
#pragma unroll
            for (int it = 0; it < 16; ++it) { const int rt = r0 + it; const unsigned a0 = ua[it], a1 = ua[it + 1], a2 = ua[it + 2], g0 = ug[it], g1 = ug[it + 1], g2 = ug[it + 2];
                if (rt < 2) { *(unsigned*)(UB + ((size_t)pm * 4 + 2 + rt) * F2 + ca) = a2; *(unsigned*)(UB + ((size_t)pm * 4 + 2 + rt) * F2 + DFF + ca) = g2; continue; }
                if (rt >= 254) { *(unsigned*)(UB + ((size_t)(pm + 1) * 4 + (rt - 254)) * F2 + ca) = a2; *(unsigned*)(UB + ((size_t)(pm + 1) * 4 + (rt - 254)) * F2 + DFF + ca) = g2; }
                const float av0 = cba[0] + wa0[0] * lo16(a0) + wa1[0] * lo16(a1) + wa2[0] * lo16(a2), av1 = cba[1] + wa0[1] * hi16(a0) + wa1[1] * hi16(a1) + wa2[1] * hi16(a2);
                const float gv0 = cbg[0] + wg0[0] * lo16(g0) + wg1[0] * lo16(g1) + wg2[0] * lo16(g2), gv1 = cbg[1] + wg0[1] * hi16(g0) + wg1[1] * hi16(g1) + wg2[1] * hi16(g2);
                *(unsigned*)(ACT + (size_t)(pm * 256 + rt) * DFF + ca) = pk2(gelu_tanh(av0) * gv0, gelu_tanh(av1) * gv1); }
            }
        }
#undef SCR_LD
        asm volatile("s_waitcnt vmcnt(0)" ::: "memory"); __builtin_amdgcn_s_barrier();
    }
};


struct EpiDownLn {
    static constexpr bool PERM = false, HAS_MID = false, AFTER_DRAIN = true;
    const float* mod; const float *bias, *gam, *bet; float* out; const bf16_t* x1; unsigned long long* xbuf; unsigned* cnt;
    __device__ __forceinline__ void fused(Acc& acc, const pg8::Unit& u, LAS unsigned char* lds) const {
        int tv_ = threadIdx.x; asm volatile("" : "+v"(tv_));
        const int lane = tv_ & 63, wid = __builtin_amdgcn_readfirstlane(tv_ >> 6), fr = lane & 15, fq = lane >> 4, wc = wid & 3, wr = wid >> 2;
        LAS f32x2* Pp = (LAS f32x2*)lds;
        LAS f32x2* S = (LAS f32x2*)(lds + 8192);
        const int col0 = u.pn * 256 + wc * 32 + 4 * fq;
        const float* g = mod + (size_t)(u.pm >> 5) * 6144 + 5120;
#pragma unroll
        for (int bj = 0; bj < 2; ++bj)
#pragma unroll
            for (int n = 0; n < 2; ++n) { const int c = col0 + bj * 128 + n * 16; const f32x4 gv = *(const f32x4*)(g + c), bv = *(const f32x4*)(bias + c);
#pragma unroll
                for (int ai = 0; ai < 2; ++ai)
#pragma unroll
                    for (int m = 0; m < 4; ++m) acc[ai][bj][m][n] = gv * (acc[ai][bj][m][n] + bv); }
#pragma unroll
        for (int ai = 0; ai < 2; ++ai)
#pragma unroll
            for (int m = 0; m < 4; ++m) { const bf16_t* xr = x1 + (size_t)(u.pm * 256 + ai * 128 + wr * 64 + m * 16 + fr) * 1024 + col0;
#pragma unroll
                for (int bj = 0; bj < 2; ++bj)
#pragma unroll
                    for (int n = 0; n < 2; ++n) { const u32x2 xw = *(const u32x2*)(xr + bj * 128 + n * 16); acc[ai][bj][m][n] = acc[ai][bj][m][n] + (f32x4){lo16(xw.x), hi16(xw.x), lo16(xw.y), hi16(xw.y)} * ALPHA; }
                asm volatile("" : "+v"(acc[ai][0][m][0]), "+v"(acc[ai][0][m][1]), "+v"(acc[ai][1][m][0]), "+v"(acc[ai][1][m][1]));
                if (m & 1) asm volatile("" ::: "memory"); }
#pragma unroll
        for (int ai = 0; ai < 2; ++ai)
#pragma unroll
            for (int m = 0; m < 4; ++m) { float s = 0.f;
#pragma unroll
                for (int bj = 0; bj < 2; ++bj)
#pragma unroll
                    for (int n = 0; n < 2; ++n) { const f32x4 x = acc[ai][bj][m][n]; s += (x[0] + x[1]) + (x[2] + x[3]); }
                s += __shfl_xor(s, 16); s += __shfl_xor(s, 32);
                const float mw = s * (1.0f / 64.0f); float q = 0.f;
#pragma unroll
                for (int bj = 0; bj < 2; ++bj)
#pragma unroll
                    for (int n = 0; n < 2; ++n) { const f32x4 d = acc[ai][bj][m][n] - mw; q += (d[0] * d[0] + d[1] * d[1]) + (d[2] * d[2] + d[3] * d[3]); }
                q += __shfl_xor(q, 16); q += __shfl_xor(q, 32);
                if (fq == 0) Pp[(ai * 128 + wr * 64 + m * 16 + fr) * 4 + wc] = (f32x2){mw, q}; }
        asm volatile("s_waitcnt lgkmcnt(0)" ::: "memory"); __builtin_amdgcn_s_barrier(); asm volatile("" ::: "memory");
        const int row = wid * 32 + (lane & 31);
        if (lane < 32) { const f32x2 a = Pp[row * 4 + 0], b = Pp[row * 4 + 1], cc = Pp[row * 4 + 2], d = Pp[row * 4 + 3];
            const float mt = (a.x + b.x + cc.x + d.x) * 0.25f; const float da = a.x - mt, db = b.x - mt, dc = cc.x - mt, dd = d.x - mt;
            const float m2 = (a.y + b.y) + (cc.y + d.y) + 64.0f * ((da * da + db * db) + (dc * dc + dd * dd));
            __hip_atomic_store(xbuf + ((size_t)(u.pm * 256 + row) * 4 + u.pn), ((unsigned long long)__float_as_uint(m2) << 32) | __float_as_uint(mt), __ATOMIC_RELAXED, __HIP_MEMORY_SCOPE_AGENT); }
        asm volatile("s_waitcnt vmcnt(0)" ::: "memory");
        if (lane == 0) __hip_atomic_fetch_add(cnt + 64 * u.pm, 1u, __ATOMIC_RELAXED, __HIP_MEMORY_SCOPE_AGENT);
        if (wid == 0) { unsigned sp = 0;
            while ((unsigned)__builtin_amdgcn_readfirstlane(__hip_atomic_load(cnt + 64 * u.pm, __ATOMIC_RELAXED, __HIP_MEMORY_SCOPE_AGENT)) < 32u) { __builtin_amdgcn_s_sleep(2); if (++sp > (1u << 24)) break; }
            __builtin_amdgcn_fence(__ATOMIC_ACQUIRE, "agent"); }
        asm volatile("s_waitcnt vmcnt(0) lgkmcnt(0)" ::: "memory"); __builtin_amdgcn_s_barrier(); asm volatile("" ::: "memory");
        if (lane < 32) { const unsigned long long* slot = xbuf + (size_t)(u.pm * 256 + row) * 4; float mt[4], m2[4]; float ms = 0.f;
#pragma unroll
            for (int t = 0; t < 4; ++t) { const unsigned long long w = __hip_atomic_load(slot + t, __ATOMIC_RELAXED, __HIP_MEMORY_SCOPE_AGENT); mt[t] = __uint_as_float((unsigned)w); m2[t] = __uint_as_float((unsigned)(w >> 32)); ms += mt[t]; }
            const float mean = ms * 0.25f; float q = 0.f;
#pragma unroll
            for (int t = 0; t < 4; ++t) { const float dm = mt[t] - mean; q += m2[t] + 256.0f * dm * dm; }
            S[row] = (f32x2){mean, 1.0f / sqrtf(q * (1.0f / 1024.0f) + LN_EPS)}; }
        asm volatile("s_waitcnt lgkmcnt(0)" ::: "memory"); __builtin_amdgcn_s_barrier(); asm volatile("" ::: "memory");
#pragma unroll
        for (int bj = 0; bj < 2; ++bj)
#pragma unroll
            for (int n = 0; n < 2; ++n) { const int c = col0 + bj * 128 + n * 16; const f32x4 gm = *(const f32x4*)(gam + c), bt = *(const f32x4*)(bet + c);
#pragma unroll
                for (int ai = 0; ai < 2; ++ai)
#pragma unroll
                    for (int m = 0; m < 4; ++m) { const int r = ai * 128 + wr * 64 + m * 16 + fr; const f32x2 sr = S[r];
                        *(f32x4*)(out + (size_t)(u.pm * 256 + r) * 1024 + c) = (acc[ai][bj][m][n] - sr.x) * sr.y * gm + bt; } }
    }
    __device__ __forceinline__ void operator()(const Acc&, const pg8::Unit&, int, int, int, int) const {}
};

struct Ctx { int tid, lane, wave, vw, nvw; };

__device__ __forceinline__ void transpose_item(const float* W, int ldw, int k0, int csrc, bf16_t* dst, int ldd, int drow, int dcol, float* scr, int lane) {
    float tv_[32];
#pragma unroll
    for (int i = 0; i < 32; ++i) tv_[i] = W[(size_t)(k0 + 2 * i + (lane >> 5)) * ldw + csrc + (lane & 31)];
#pragma unroll
    for (int i = 0; i < 32; ++i) scr[(2 * i + (lane >> 5)) * 33 + (lane & 31)] = tv_[i];
    __builtin_amdgcn_fence(__ATOMIC_RELEASE, "wavefront"); asm volatile("s_waitcnt lgkmcnt(0)" ::: "memory");
    const int c = lane & 7;
#pragma unroll
    for (int j = 0; j < 4; ++j) { const int n = (lane >> 3) + 8 * j; const float* s = scr + (8 * c) * 33 + n;
        u32x4 o; o.x = pk2(s[0 * 33], s[1 * 33]); o.y = pk2(s[2 * 33], s[3 * 33]); o.z = pk2(s[4 * 33], s[5 * 33]); o.w = pk2(s[6 * 33], s[7 * 33]);
        *(u32x4*)(dst + (size_t)(drow + n) * ldd + dcol + k0 + 8 * c) = o; }
    asm volatile("s_waitcnt lgkmcnt(0)" ::: "memory");
}
__device__ __forceinline__ int srcmap(int c) { return c < 2048 ? c : (c < 3584 ? c + 1032 : (c < 4608 ? c - 1528 : c + 8)); }

__device__ __forceinline__ void ada_task(PP P, int task, int lane) {
    const int n0 = (task / 3) * 16, rt0 = (task % 3) * 3, fr = lane & 15, kg = lane >> 4;
    f32x4 acc[3];
#pragma unroll
    for (int r = 0; r < 3; ++r) acc[r] = (f32x4){0.f, 0.f, 0.f, 0.f};
    const float* crow[3];
#pragma unroll
    for (int r = 0; r < 3; ++r) { int s = 16 * (rt0 + r) + fr; if (s > NSEQ - 1) s = NSEQ - 1; crow[r] = s < 2 ? P->c_p + (size_t)s * D : P->c_s + (size_t)(s - 2) * D; }
#pragma unroll 4
    for (int ks = 0; ks < 32; ++ks) { const int k0 = ks * 32 + 8 * kg;
        float wv[8];
#pragma unroll
        for (int j = 0; j < 8; ++j) wv[j] = P->w_ada[(size_t)(k0 + j) * 6144 + n0 + fr];
        bf16x8 b;
#pragma unroll
        for (int j = 0; j < 8; ++j) b[j] = (short)f2bf(wv[j]);
#pragma unroll
        for (int r = 0; r < 3; ++r) { const f32x4 c0 = *(const f32x4*)(crow[r] + k0), c1 = *(const f32x4*)(crow[r] + k0 + 4);
            bf16x8 a;
#pragma unroll
            for (int j = 0; j < 4; ++j) { a[j] = (short)f2bf(c0[j] * sigmoidf_(c0[j])); a[4 + j] = (short)f2bf(c1[j] * sigmoidf_(c1[j])); }
            acc[r] = __builtin_amdgcn_mfma_f32_16x16x32_bf16(a, b, acc[r], 0, 0, 0); } }
    float* mod = (float*)(P->ws + WS_MOD); const float bb = P->b_ada[n0 + fr];
#pragma unroll
    for (int r = 0; r < 3; ++r)
#pragma unroll
        for (int j = 0; j < 4; ++j) { const int s = 16 * (rt0 + r) + 4 * kg + j; if (s < NSEQ) mod[(size_t)s * 6144 + n0 + fr] = acc[r][j] + bb; }
}

constexpr int APITCH = 1032;
__device__ __forceinline__ void ada_block_task(PP P, unsigned char* lds, const Ctx& c, int task) {
    const int rg = task % 3, cg = task / 3, fr = c.lane & 15, kg = c.lane >> 4;
    bf16_t* As = (bf16_t*)lds;
#pragma unroll 12
    for (int i = 0; i < 24; ++i) { const int id = c.tid + 512 * i, r = id >> 8, k4 = id & 255; int s = 48 * rg + r; s = s > NSEQ - 1 ? NSEQ - 1 : s;
        const float* src = s < 2 ? P->c_p + (size_t)s * D : P->c_s + (size_t)(s - 2) * D; const f32x4 v = *(const f32x4*)(src + 4 * k4);
        u32x2 w; w.x = pk2(v[0] * sigmoidf_(v[0]), v[1] * sigmoidf_(v[1])); w.y = pk2(v[2] * sigmoidf_(v[2]), v[3] * sigmoidf_(v[3]));
        *(u32x2*)(As + r * APITCH + 4 * k4) = w; }
    __syncthreads();
    const int n0 = 128 * cg + 16 * c.wave;
    f32x4 acc[3];
#pragma unroll
    for (int r = 0; r < 3; ++r) acc[r] = (f32x4){0.f, 0.f, 0.f, 0.f};
#pragma unroll 8
    for (int ks = 0; ks < 32; ++ks) { const int k0 = ks * 32 + 8 * kg;
        float wv[8];
#pragma unroll
        for (int j = 0; j < 8; ++j) wv[j] = P->w_ada[(size_t)(k0 + j) * 6144 + n0 + fr];
        u32x4 bw; bw.x = pk2(wv[0], wv[1]); bw.y = pk2(wv[2], wv[3]); bw.z = pk2(wv[4], wv[5]); bw.w = pk2(wv[6], wv[7]);
        const bf16x8 b = __builtin_bit_cast(bf16x8, bw);
#pragma unroll
        for (int r = 0; r < 3; ++r) { const bf16x8 a = *(const bf16x8*)(As + (16 * r + fr) * APITCH + k0); acc[r] = __builtin_amdgcn_mfma_f32_16x16x32_bf16(a, b, acc[r], 0, 0, 0); } }
    float* mod = (float*)(P->ws + WS_MOD); const float bb = P->b_ada[n0 + fr];
#pragma unroll
    for (int r = 0; r < 3; ++r)
#pragma unroll
        for (int j = 0; j < 4; ++j) { const int s = 48 * rg + 16 * r + 4 * kg + j; if (s < NSEQ) mod[(size_t)s * 6144 + n0 + fr] = acc[r][j] + bb; }
    __syncthreads();
}

__device__ __forceinline__ void phase0(PP P, unsigned char* lds, const Ctx& c) {
    float* scr = (float*)(lds + c.wave * 16384);
    { float* wg = (float*)(P->ws + WS_MISC + MISC_WG); float* bz = (float*)(P->ws + WS_MISC + MISC_BIASZ);
      for (int i = blockIdx.x * 512 + c.tid; i < 8192; i += gridDim.x * 512) { const int g = i >> 10, k = i & 1023; wg[i] = P->w_in[(size_t)k * DIN + 2048 + g]; }
      for (int i = blockIdx.x * 512 + c.tid; i < N1; i += gridDim.x * 512) bz[i] = P->b_in[srcmap(i)]; }
    constexpr int T_ADA = 144, I_IN = 16 * 208;
    const int G = gridDim.x, bid = blockIdx.x;
    if (G > T_ADA) {
        if (bid < T_ADA) { ada_block_task(P, lds, c, bid); return; }
        const int tv = (bid - T_ADA) * 8 + c.wave, tn = (G - T_ADA) * 8;
        for (int r = tv; r < I_IN; r += tn) { const int kb = r / 208, nb = r % 208; transpose_item(P->w_in, DIN, 64 * kb, srcmap(32 * nb), (bf16_t*)(P->ws + WS_W1T), 1024, 32 * nb, 0, scr, c.lane); }
    } else {
        for (int t = bid; t < T_ADA; t += G) ada_block_task(P, lds, c, t);
        for (int r = bid * 8 + c.wave; r < I_IN; r += G * 8) { const int kb = r / 208, nb = r % 208; transpose_item(P->w_in, DIN, 64 * kb, srcmap(32 * nb), (bf16_t*)(P->ws + WS_W1T), 1024, 32 * nb, 0, scr, c.lane); }
    }
}

__device__ __forceinline__ void late_copies_a(PP P, unsigned char* lds, const Ctx& c, int rank, int nrk) {
    float* scr = (float*)(lds + c.wave * 16384); constexpr int I_B = 512, I_UP = 16 * 176;
    for (int r = rank; r < I_B; r += nrk) { const int kb = r / 32, nb = r % 32; transpose_item(P->w_bm, 1024, 64 * kb, 32 * nb, (bf16_t*)(P->ws + WS_WBR), 2048, 32 * nb, 0, scr, c.lane); }
    for (int r = rank; r < I_B; r += nrk) { const int kb = r / 32, nb = r % 32; transpose_item(P->w_ba, 1024, 64 * kb, 32 * nb, (bf16_t*)(P->ws + WS_WBR), 2048, 32 * nb, 1024, scr, c.lane); }
    for (int r = rank; r < I_B; r += nrk) { const int kb = r / 32, nb = r % 32; transpose_item(P->w_out, 1024, 64 * kb, 32 * nb, (bf16_t*)(P->ws + WS_WOT), 1024, 32 * nb, 0, scr, c.lane); }
    for (int r = rank; r < I_UP; r += nrk) { const int kb = r / 176, nb = r % 176; const int cs = 32 * nb; const int j = cs < DFF ? cs : cs - DFF; const int drow = 256 * (j >> 7) + (cs < DFF ? 0 : 128) + (j & 127);
        transpose_item(P->w_up, F2, 64 * kb, cs, (bf16_t*)(P->ws + WS_WUT), 1024, drow, 0, scr, c.lane); }
}
__device__ __forceinline__ void late_copies_b(PP P, unsigned char* lds, const Ctx& c, int rank, int nrk) {
    float* scr = (float*)(lds + c.wave * 16384); constexpr int I_DN = 44 * 32;
    for (int r = rank; r < I_DN; r += nrk) { const int kb = r / 32, nb = r % 32; transpose_item(P->w_down, 1024, 64 * kb, 32 * nb, (bf16_t*)(P->ws + WS_WDT), DFF, 32 * nb, 0, scr, c.lane); }
}

__device__ __forceinline__ void ln_stats(const f32x4 (&v)[4], float& mean, float& rstd) {
    float s = 0.f, q = 0.f;
#pragma unroll
    for (int j = 0; j < 4; ++j) { s += (v[j][0] + v[j][1]) + (v[j][2] + v[j][3]); q += (v[j][0] * v[j][0] + v[j][1] * v[j][1]) + (v[j][2] * v[j][2] + v[j][3] * v[j][3]); }
#pragma unroll
    for (int o = 1; o < 64; o <<= 1) { s += __shfl_xor(s, o); q += __shfl_xor(q, o); }
    mean = s * (1.f / D);
    rstd = rsqrtf(fmaxf(q * (1.f / D) - mean * mean, 0.f) + LN_EPS);
}
__device__ __forceinline__ void phase1(PP P, const Ctx& c, bf16_t* H) {
    const float* mod = (const float*)(P->ws + WS_MOD); const float* wg = (const float*)(P->ws + WS_MISC + MISC_WG); float* gates = (float*)(P->ws + WS_GATES);
    f32x4 wgr[8][4];
#pragma unroll
    for (int g = 0; g < 8; ++g)
#pragma unroll
        for (int j = 0; j < 4; ++j) wgr[g][j] = *(const f32x4*)(wg + g * 1024 + 4 * c.lane + 256 * j);
    const int gsel = ((c.lane >> 5) & 1) * 4 + ((c.lane >> 4) & 1) * 2 + ((c.lane >> 3) & 1); const float gbias = P->b_in[2048 + gsel];
    f32x4 nv[4];
    if (c.vw < MT) { const int row = c.vw; const float* xr = row < MP ? P->x_p + (size_t)row * D : P->x_s + (size_t)(row - MP) * D;
#pragma unroll
        for (int j = 0; j < 4; ++j) nv[j] = *(const f32x4*)(xr + 4 * c.lane + 256 * j); }
    int cseq = -1; f32x4 shr[4], scr1[4];
    for (int row = c.vw; row < MT; row += c.nvw) {
        { const int sq = seq_of_row(row); if (sq != cseq) { cseq = sq; const float* mr = mod + (size_t)sq * 6144;
#pragma unroll
            for (int j = 0; j < 4; ++j) { shr[j] = *(const f32x4*)(mr + 4 * c.lane + 256 * j); scr1[j] = *(const f32x4*)(mr + 1024 + 4 * c.lane + 256 * j) + 1.f; } } }
        f32x4 v[4];
#pragma unroll
        for (int j = 0; j < 4; ++j) v[j] = nv[j];
        { const int nr = row + c.nvw; if (nr < MT) { const float* xr = nr < MP ? P->x_p + (size_t)nr * D : P->x_s + (size_t)(nr - MP) * D;
#pragma unroll
            for (int j = 0; j < 4; ++j) nv[j] = *(const f32x4*)(xr + 4 * c.lane + 256 * j); } }
        float mean, rstd; ln_stats(v, mean, rstd);
#pragma unroll
        for (int j = 0; j < 4; ++j) { v[j] = (v[j] - mean) * rstd * scr1[j] + shr[j];
            u32x2 w; w.x = pk2(v[j][0], v[j][1]); w.y = pk2(v[j][2], v[j][3]); *(u32x2*)(H + (size_t)row * D + 4 * c.lane + 256 * j) = w; }
        float gs[8];
#pragma unroll
        for (int g = 0; g < 8; ++g) { float s = 0.f;
#pragma unroll
            for (int j = 0; j < 4; ++j) { const f32x4 w = wgr[g][j]; s += (v[j][0] * w[0] + v[j][1] * w[1]) + (v[j][2] * w[2] + v[j][3] * w[3]); }
            gs[g] = s; }
        { const bool u5 = (c.lane & 32) != 0, u4 = (c.lane & 16) != 0, u3 = (c.lane & 8) != 0; float a4[4], a2[2], a1;
#pragma unroll
          for (int k = 0; k < 4; ++k) { const float send = u5 ? gs[k] : gs[k + 4], keep = u5 ? gs[k + 4] : gs[k]; a4[k] = keep + __shfl_xor(send, 32); }
#pragma unroll
          for (int k = 0; k < 2; ++k) { const float send = u4 ? a4[k] : a4[k + 2], keep = u4 ? a4[k + 2] : a4[k]; a2[k] = keep + __shfl_xor(send, 16); }
          { const float send = u3 ? a2[0] : a2[1], keep = u3 ? a2[1] : a2[0]; a1 = keep + __shfl_xor(send, 8); }
          a1 += __shfl_xor(a1, 4); a1 += __shfl_xor(a1, 2); a1 += __shfl_xor(a1, 1);
          if ((c.lane & 7) == 0) gates[(size_t)row * 8 + gsel] = a1 + gbias; }
    }
}
__device__ __forceinline__ void phase8(PP P, const Ctx& c, bf16_t* H) {
    const float* mod = (const float*)(P->ws + WS_MOD); const bf16_t* XP = (const bf16_t*)(P->ws + WS_XP); bf16_t* X1 = (bf16_t*)(P->ws + WS_X1);
    f32x4 g1v[4], b1v[4];
#pragma unroll
    for (int j = 0; j < 4; ++j) { g1v[j] = *(const f32x4*)(P->ln1g + 4 * c.lane + 256 * j); b1v[j] = *(const f32x4*)(P->ln1b + 4 * c.lane + 256 * j); }
    u32x2 nv[4];
    if (c.vw < MT) {
#pragma unroll
        for (int j = 0; j < 4; ++j) nv[j] = *(const u32x2*)(XP + (size_t)c.vw * D + 4 * c.lane + 256 * j); }
    int cseq = -1; f32x4 shr[4], scr1[4];
    for (int row = c.vw; row < MT; row += c.nvw) {
        { const int sq = seq_of_row(row); if (sq != cseq) { cseq = sq; const float* mr = mod + (size_t)sq * 6144;
#pragma unroll
            for (int j = 0; j < 4; ++j) { shr[j] = *(const f32x4*)(mr + 3072 + 4 * c.lane + 256 * j); scr1[j] = *(const f32x4*)(mr + 4096 + 4 * c.lane + 256 * j) + 1.f; } } }
        f32x4 v[4];
#pragma unroll
        for (int j = 0; j < 4; ++j) v[j] = (f32x4){lo16(nv[j].x), hi16(nv[j].x), lo16(nv[j].y), hi16(nv[j].y)};
        { const int nr = row + c.nvw; if (nr < MT) {
#pragma unroll
            for (int j = 0; j < 4; ++j) nv[j] = *(const u32x2*)(XP + (size_t)nr * D + 4 * c.lane + 256 * j); } }
        float mean, rstd; ln_stats(v, mean, rstd);
#pragma unroll
        for (int j = 0; j < 4; ++j) { v[j] = (v[j] - mean) * rstd * g1v[j] + b1v[j];
            u32x2 w; w.x = pk2(v[j][0], v[j][1]); w.y = pk2(v[j][2], v[j][3]); *(u32x2*)(X1 + (size_t)row * D + 4 * c.lane + 256 * j) = w; }
        ln_stats(v, mean, rstd);
#pragma unroll
        for (int j = 0; j < 4; ++j) { const f32x4 h = (v[j] - mean) * rstd * scr1[j] + shr[j];
            u32x2 w; w.x = pk2(h[0], h[1]); w.y = pk2(h[2], h[3]); *(u32x2*)(H + (size_t)row * D + 4 * c.lane + 256 * j) = w; }
    }
}
__device__ __forceinline__ void phase12(PP P, const Ctx& c) {
    for (int row = MP + c.vw; row < MT; row += c.nvw) {
        float* xr = P->out + (size_t)row * D;
        f32x4 v[4];
#pragma unroll
        for (int j = 0; j < 4; ++j) v[j] = *(const f32x4*)(xr + 4 * c.lane + 256 * j);
        float mean, rstd; ln_stats(v, mean, rstd);
#pragma unroll
        for (int j = 0; j < 4; ++j) { const f32x4 g = *(const f32x4*)(P->ln2g + 4 * c.lane + 256 * j), b = *(const f32x4*)(P->ln2b + 4 * c.lane + 256 * j);
            *(f32x4*)(xr + 4 * c.lane + 256 * j) = (v[j] - mean) * rstd * g + b; }
    }
}

__device__ __forceinline__ float log_sigmoid(float x) { return fminf(x, 0.f) - log1pf(__expf(-fabsf(x))); }
__device__ __forceinline__ void chunk_gates(PP P, float* sm, int row0, int h, const Ctx& c) {
    if (c.wave == 0) {
        const float* gates = (const float*)(P->ws + WS_GATES); const int l = c.lane;
        const float* g0 = gates + (size_t)(row0 + 2 * l) * 8;
        const float f0 = log_sigmoid(g0[4 + h]), f1 = log_sigmoid(g0[12 + h]), i0 = g0[h], i1 = g0[8 + h];
        float x = f0 + f1;
#pragma unroll
        for (int o = 1; o < 64; o <<= 1) { const float t = __shfl_up(x, o); if (l >= o) x += t; }
        const float b1 = x, b0 = x - f1, a0 = i0 - b0, a1 = i1 - b1;
        float m = fmaxf(a0, a1);
#pragma unroll
        for (int o = 1; o < 64; o <<= 1) { const float t = __shfl_up(m, o); if (l >= o) m = fmaxf(m, t); }
        float mp = __shfl_up(m, 1); if (l == 0) mp = -INFINITY;
        *(f32x2*)(sm + 2 * l) = (f32x2){f0, f1}; *(f32x2*)(sm + 128 + 2 * l) = (f32x2){i0, i1}; *(f32x2*)(sm + 256 + 2 * l) = (f32x2){b0, b1};
        *(f32x2*)(sm + 384 + 2 * l) = (f32x2){a0, a1}; *(f32x2*)(sm + 512 + 2 * l) = (f32x2){fmaxf(mp, a0), m};
    }
    __syncthreads();
}
constexpr int LP = 136;

__device__ __forceinline__ void mlstm_local_unit(PP P, unsigned char* lds, const Ctx& c, int unit) {
    const int bh = unit >> 6, ch = unit & 63, b = bh >> 2, h = bh & 3, row0 = b * SEQ + ch * 128;
    bf16_t* vT = (bf16_t*)lds; bf16_t* kT = (bf16_t*)(lds + 256 * LP * 2); float* sm = (float*)(lds + 384 * LP * 2); float* sw = sm + 640;
    const bf16_t* Z0 = (const bf16_t*)(P->ws + WS_Z0); const bf16_t* Z1 = (const bf16_t*)(P->ws + WS_Z1);
    u32x4 rv[8], rkk[4];
#pragma unroll
    for (int i = 0; i < 8; ++i) { const int s = (c.lane >> 1) + 32 * (i & 3), c8 = 4 * c.wave + 2 * (i >> 2) + (c.lane & 1); rv[i] = *(const u32x4*)(Z1 + (size_t)(row0 + s) * 2048 + 256 * h + 8 * c8); }
#pragma unroll
    for (int i = 0; i < 4; ++i) { const int s = (c.lane >> 1) + 32 * i, c8 = 2 * c.wave + (c.lane & 1); rkk[i] = *(const u32x4*)(Z0 + (size_t)(row0 + s) * 1024 + 512 + 128 * h + 8 * c8); }
    chunk_gates(P, sm, row0, h, c);
    const float AT = sm[512 + 127], bT = sm[256 + 127];
    if (c.tid < 128) sw[c.tid] = __expf(sm[384 + c.tid] - AT);
    if (c.tid == 0) { float* chs = (float*)(P->ws + WS_MISC + MISC_CH); chs[(bh * 64 + ch) * 2] = bT; chs[(bh * 64 + ch) * 2 + 1] = AT; }
    __syncthreads();
#pragma unroll
    for (int i = 0; i < 8; ++i) { const int s = (c.lane >> 1) + 32 * (i & 3), c8 = 4 * c.wave + 2 * (i >> 2) + (c.lane & 1); const u32x4 x = rv[i]; const float w = sw[s];
#pragma unroll
        for (int q = 0; q < 4; ++q) { vT[(8 * c8 + 2 * q) * LP + s] = (bf16_t)f2bf(lo16(x[q]) * w); vT[(8 * c8 + 2 * q + 1) * LP + s] = (bf16_t)f2bf(hi16(x[q]) * w); } }
#pragma unroll
    for (int i = 0; i < 4; ++i) { const int s = (c.lane >> 1) + 32 * i, c8 = 2 * c.wave + (c.lane & 1); const u32x4 x = rkk[i];
#pragma unroll
        for (int q = 0; q < 4; ++q) { kT[(8 * c8 + 2 * q) * LP + s] = (bf16_t)(x[q] & 0xffffu); kT[(8 * c8 + 2 * q + 1) * LP + s] = (bf16_t)(x[q] >> 16); } }
    __syncthreads();
    { const int d = c.tid & 127, part = c.tid >> 7; float s = 0.f;
#pragma unroll
      for (int i = 0; i < 4; ++i) { const u32x4 x = *(const u32x4*)(kT + d * LP + 32 * part + 8 * i);
#pragma unroll
          for (int q = 0; q < 4; ++q) s += lo16(x[q]) * sw[32 * part + 8 * i + 2 * q] + hi16(x[q]) * sw[32 * part + 8 * i + 2 * q + 1]; }
      sw[128 + c.tid] = s; }
    const int ql = c.lane & 31, hh = c.lane >> 5;
    f32x16 acc[4];
#pragma unroll
    for (int i = 0; i < 4; ++i)
#pragma unroll
        for (int r = 0; r < 16; ++r) acc[i][r] = 0.f;
#pragma unroll
    for (int ks = 0; ks < 8; ++ks) { const bf16x8 bv = *(const bf16x8*)(vT + (32 * c.wave + ql) * LP + 16 * ks + 8 * hh);
#pragma unroll
        for (int i = 0; i < 4; ++i) { const bf16x8 ak = *(const bf16x8*)(kT + (32 * i + ql) * LP + 16 * ks + 8 * hh); acc[i] = __builtin_amdgcn_mfma_f32_32x32x16_bf16(ak, bv, acc[i], 0, 0, 0); } }
    bf16_t* U = (bf16_t*)P->out + (size_t)(bh * 64 + ch) * 32768 + (size_t)(32 * c.wave + ql) * 128;
#pragma unroll
    for (int i = 0; i < 4; ++i)
#pragma unroll
        for (int g4 = 0; g4 < 4; ++g4) { u32x2 w; w.x = pk2(acc[i][4 * g4], acc[i][4 * g4 + 1]); w.y = pk2(acc[i][4 * g4 + 2], acc[i][4 * g4 + 3]); *(u32x2*)(U + 32 * i + 8 * g4 + 4 * hh) = w; }
    __syncthreads();
    if (c.tid < 128) ((float*)(P->ws + WS_MISC + MISC_UN))[(size_t)(bh * 64 + ch) * 128 + c.tid] = (sw[128 + c.tid] + sw[256 + c.tid]) + (sw[384 + c.tid] + sw[512 + c.tid]);
    __syncthreads();
}

__device__ __forceinline__ void swa_prompt_unit(PP P, unsigned char* lds, const Ctx& c, int unit) {
    const int qb = unit & 127, kvh = (unit >> 7) & 3, b = unit >> 9, q0 = qb * 64, key0 = q0 - 128;
    bf16_t* Ks = (bf16_t*)lds; bf16_t* VT = (bf16_t*)(lds + 192 * 72 * 2);
    bf16_t* Z1 = (bf16_t*)(P->ws + WS_Z1); const bf16_t* Z2 = (const bf16_t*)(P->ws + WS_Z2);
#pragma unroll
    for (int i = 0; i < 3; ++i) { const int key = (c.lane >> 1) + 32 * (2 * i + (c.wave >> 2)), c8 = 2 * (c.wave & 3) + (c.lane & 1), kpos = key0 + key;
        u32x4 kx = (u32x4){0u, 0u, 0u, 0u}, vx = kx;
        if (kpos >= 0) { const bf16_t* rp = Z2 + (size_t)(b * SEQ + kpos) * 512 + kvh * 64 + 8 * c8; kx = *(const u32x4*)rp; vx = *(const u32x4*)(rp + 256); }
        *(u32x4*)(Ks + key * 72 + 8 * c8) = kx;
#pragma unroll
        for (int q = 0; q < 4; ++q) { VT[(8 * c8 + 2 * q) * 200 + key] = (bf16_t)(vx[q] & 0xffffu); VT[(8 * c8 + 2 * q + 1) * 200 + key] = (bf16_t)(vx[q] >> 16); } }
    __syncthreads();
    const int g = c.wave & 3, half = c.wave >> 2, head = 4 * kvh + g, ql = c.lane & 31, hh = c.lane >> 5;
    const size_t qrow = (size_t)b * SEQ + q0 + 32 * half + ql;
    bf16_t* qp = Z1 + qrow * 2048 + 1024 + head * 64;
    bf16x8 qf[4];
#pragma unroll
    for (int ks = 0; ks < 4; ++ks) qf[ks] = *(const bf16x8*)(qp + 16 * ks + 8 * hh);
    f32x16 st[5];
#pragma unroll
    for (int kt = 0; kt < 5; ++kt) {
#pragma unroll
        for (int r = 0; r < 16; ++r) st[kt][r] = 0.f;
#pragma unroll
        for (int ks = 0; ks < 4; ++ks) { const bf16x8 a = *(const bf16x8*)(Ks + (32 * half + 32 * kt + ql) * 72 + 16 * ks + 8 * hh); st[kt] = __builtin_amdgcn_mfma_f32_32x32x16_bf16(a, qf[ks], st[kt], 0, 0, 0); } }
    const float slope = exp2f(-0.5f * (float)(head + 1)), sink = P->sinks[head];
    float mx = sink;
    {
        const float nsl = -slope, bf = (float)(ql - 4 * hh); const int qh = ql - 4 * hh, kp0 = q0 + 32 * half - 128 + 4 * hh; const bool edge = q0 < 128;
#pragma unroll
        for (int kt = 0; kt < 5; ++kt)
#pragma unroll
            for (int r = 0; r < 16; ++r) { const int kc = (r & 3) + 8 * (r >> 2);
                float s = nsl * (bf + (float)(128 - 32 * kt - kc)) + st[kt][r];
                if (kt == 0) s = (kc > qh) ? s : -INFINITY;
                if (kt == 4) s = (kc <= qh) ? s : -INFINITY;
                if (edge && kt < 4) s = (kp0 + 32 * kt + kc >= 0) ? s : -INFINITY;
                st[kt][r] = s; mx = fmaxf(mx, s); } }
    mx = fmaxf(mx, __shfl_xor(mx, 32));
    float sum = 0.f;
#pragma unroll
    for (int kt = 0; kt < 5; ++kt)
#pragma unroll
        for (int r = 0; r < 16; ++r) { const float p = __expf(st[kt][r] - mx); st[kt][r] = p; sum += p; }
    sum += __shfl_xor(sum, 32);
    const float inv = 1.f / (sum + __expf(sink - mx));
    f32x16 ot[2];
#pragma unroll
    for (int db = 0; db < 2; ++db)
#pragma unroll
        for (int r = 0; r < 16; ++r) ot[db][r] = 0.f;
#pragma unroll
    for (int kt = 0; kt < 5; ++kt)
#pragma unroll
        for (int a2 = 0; a2 < 2; ++a2) { bf16x8 pb;
#pragma unroll
            for (int j = 0; j < 8; ++j) pb[j] = (short)f2bf(st[kt][8 * a2 + j]);
#pragma unroll
            for (int db = 0; db < 2; ++db) { const bf16_t* vp = VT + (32 * db + ql) * 200 + 32 * half + 32 * kt + 16 * a2 + 4 * hh;
                const u32x2 v0 = *(const u32x2*)vp, v1 = *(const u32x2*)(vp + 8); u32x4 vv; vv.x = v0.x; vv.y = v0.y; vv.z = v1.x; vv.w = v1.y;
                ot[db] = __builtin_amdgcn_mfma_f32_32x32x16_bf16(__builtin_bit_cast(bf16x8, vv), pb, ot[db], 0, 0, 0); } }
#pragma unroll
    for (int db = 0; db < 2; ++db)
#pragma unroll
        for (int g4 = 0; g4 < 4; ++g4) { const int d = 32 * db + 8 * g4 + 4 * hh; u32x2 w; w.x = pk2(ot[db][4 * g4] * inv, ot[db][4 * g4 + 1] * inv); w.y = pk2(ot[db][4 * g4 + 2] * inv, ot[db][4 * g4 + 3] * inv);
            *(u32x2*)(qp + d) = w; }
    __syncthreads();
}

__device__ __forceinline__ void mlstm_sample_unit(PP P, unsigned char* lds, const Ctx& c, int unit) {
    const int b = unit >> 2, h = unit & 3, row0 = MP + 4 * b, tid = c.tid;
    float* sq = (float*)lds; float* sk = sq + 512; float* sv = sk + 512; float* sqk = sv + 1024; float* snq = sqk + 16; float* shv = snq + 4;
    const float* gates = (const float*)(P->ws + WS_GATES); const bf16_t* Z0 = (const bf16_t*)(P->ws + WS_Z0); bf16_t* Z1 = (bf16_t*)(P->ws + WS_Z1); const bf16_t* Z3 = (const bf16_t*)(P->ws + WS_Z3);
    const int chunk = tid & 31, rbase = tid >> 5; const size_t cbase = (size_t)(b * 4 + h) * 32768 + 4 * chunk;
    f32x4 cA[8];
#pragma unroll
    for (int j = 0; j < 8; ++j) cA[j] = *(const f32x4*)(P->st_C + cbase + (size_t)(rbase + 16 * j) * 128);
    float ig[4], bb[4], aa[4], AA[4], Mt[4], ain[4], einv[4], wsv[4];
    { float run = 0.f, mxa = -INFINITY;
#pragma unroll
      for (int t = 0; t < 4; ++t) { ig[t] = gates[(size_t)(row0 + t) * 8 + h]; run += log_sigmoid(gates[(size_t)(row0 + t) * 8 + 4 + h]); bb[t] = run; aa[t] = ig[t] - run; mxa = fmaxf(mxa, aa[t]); AA[t] = mxa; } }
    const float m0 = P->st_m[b * 4 + h];
#pragma unroll
    for (int t = 0; t < 4; ++t) { Mt[t] = fmaxf(m0, AA[t]); ain[t] = __expf(m0 - Mt[t]); einv[t] = __expf(-(bb[t] + Mt[t])); }
    const float MTl = Mt[3], decay = __expf(m0 - MTl), m_new = bb[3] + MTl;
#pragma unroll
    for (int s = 0; s < 4; ++s) wsv[s] = __expf(aa[s] - MTl);
    { const int t = tid >> 7, d = tid & 127; sq[tid] = bf2f(Z0[(size_t)(row0 + t) * 1024 + 128 * h + d]); sk[tid] = bf2f(Z0[(size_t)(row0 + t) * 1024 + 512 + 128 * h + d]);
#pragma unroll
      for (int i = 0; i < 2; ++i) { const int id = tid + 512 * i, tt = id >> 8, vc = id & 255; sv[id] = bf2f(Z1[(size_t)(row0 + tt) * 2048 + 256 * h + vc]); } }
    __syncthreads();
    { const float* n0 = P->st_n + (size_t)(b * 4 + h) * 128;
#pragma unroll
      for (int k = 0; k < 3; ++k) { const int i = c.wave + 8 * k;
          if (i < 20) { float p;
              if (i < 16) { const int t = i >> 2, s = i & 3; p = sq[t * 128 + c.lane] * sk[s * 128 + c.lane] + sq[t * 128 + 64 + c.lane] * sk[s * 128 + 64 + c.lane]; }
              else { const int t = i - 16; p = n0[c.lane] * sq[t * 128 + c.lane] + n0[64 + c.lane] * sq[t * 128 + 64 + c.lane]; }
              p = wave_sum(p); if (c.lane == 0) { if (i < 16) sqk[i] = p; else snq[i - 16] = p; } } } }
    __syncthreads();
    float smat[4][4], dinv[4];
#pragma unroll
    for (int t = 0; t < 4; ++t) { float den = 0.f;
#pragma unroll
        for (int s = 0; s < 4; ++s) { smat[t][s] = (s <= t) ? sqk[t * 4 + s] * __expf(aa[s] - Mt[t]) : 0.f; den += smat[t][s]; }
        den += ain[t] * snq[t]; dinv[t] = 1.f / fmaxf(fabsf(den), einv[t]); }
    {
      f32x4 cB[8];
#pragma unroll
      for (int j = 0; j < 8; ++j) cB[j] = *(const f32x4*)(P->st_C + cbase + (size_t)(rbase + 16 * (j + 8)) * 128);
      f32x4 q4[4], k4[4];
#pragma unroll
      for (int t = 0; t < 4; ++t) { q4[t] = *(const f32x4*)(sq + t * 128 + 4 * chunk); k4[t] = *(const f32x4*)(sk + t * 128 + 4 * chunk); }
#pragma unroll
      for (int j = 0; j < 16; ++j) { const int row = rbase + 16 * j;
          const f32x4 c4 = j < 8 ? cA[j & 7] : cB[j & 7];
          float p[4]; f32x4 nw = c4 * decay;
#pragma unroll
          for (int t = 0; t < 4; ++t) { p[t] = (c4[0] * q4[t][0] + c4[1] * q4[t][1]) + (c4[2] * q4[t][2] + c4[3] * q4[t][3]); nw = nw + k4[t] * (wsv[t] * sv[t * 256 + row]); }
          *(f32x4*)(P->out + O_SC + cbase + (size_t)row * 128) = nw;
#pragma unroll
          for (int o = 1; o < 32; o <<= 1) {
#pragma unroll
              for (int t = 0; t < 4; ++t) p[t] += __shfl_xor(p[t], o); }
          if (chunk == 0) {
#pragma unroll
              for (int t = 0; t < 4; ++t) { float num = ain[t] * p[t];
#pragma unroll
                  for (int s = 0; s < 4; ++s) num += smat[t][s] * sv[s * 256 + row];
                  shv[t * 256 + row] = num * dinv[t]; } } } }
    if (tid < 128) { const float* n0 = P->st_n + (size_t)(b * 4 + h) * 128; float a = decay * n0[tid];
#pragma unroll
        for (int s = 0; s < 4; ++s) a += wsv[s] * sk[s * 128 + tid];
        P->out[O_SN + (size_t)(b * 4 + h) * 128 + tid] = a; }
    if (tid == 0) P->out[O_SM + b * 4 + h] = m_new;
    __syncthreads();
    if (c.wave < 4) { const int t = c.wave; float x[4], s = 0.f;
#pragma unroll
        for (int i = 0; i < 4; ++i) { x[i] = shv[t * 256 + c.lane + 64 * i]; s += x[i]; }
        const float mean = wave_sum(s) * (1.f / 256.f); float q = 0.f;
#pragma unroll
        for (int i = 0; i < 4; ++i) { x[i] -= mean; q += x[i] * x[i]; }
        const float rstd = 1.f / sqrtf(wave_sum(q) * (1.f / 256.f) + LN_EPS);
#pragma unroll
        for (int i = 0; i < 4; ++i) { const int vc = 256 * h + c.lane + 64 * i; const float og = bf2f(Z3[(size_t)(row0 + t) * 1024 + vc]);
            Z1[(size_t)(row0 + t) * 2048 + vc] = (bf16_t)f2bf(x[i] * rstd * P->mnorm[vc] * og); } }
    __syncthreads();
}

__device__ __forceinline__ void swa_sample_unit(PP P, unsigned char* lds, const Ctx& c, int unit) {
    const int b = unit >> 2, kvh = unit & 3, row0 = MP + 4 * b, tid = c.tid;
    constexpr int KP = 68;
    float* sK = (float*)lds; float* sV = sK + 132 * KP; float* sQ = sV + 132 * KP; float* sP = sQ + 1024;
    bf16_t* Z1 = (bf16_t*)(P->ws + WS_Z1); const bf16_t* Z2 = (const bf16_t*)(P->ws + WS_Z2);
    { f32x4 kx[4], vx[4];
#pragma unroll
      for (int i = 0; i < 4; ++i) { const int j = tid + 512 * i, idx = j >> 4, d4 = j & 15; const size_t o = ((size_t)(b * 128 + idx) * 4 + kvh) * 64 + 4 * d4; kx[i] = *(const f32x4*)(P->ck + o); vx[i] = *(const f32x4*)(P->cv + o); }
#pragma unroll
      for (int i = 0; i < 4; ++i) { const int j = tid + 512 * i, idx = j >> 4, d4 = j & 15;
          *(f32x4*)(sK + idx * KP + 4 * d4) = kx[i]; *(f32x4*)(sV + idx * KP + 4 * d4) = vx[i];
          if (idx >= 4) { const size_t o = ((size_t)(b * 128 + idx - 4) * 4 + kvh) * 64 + 4 * d4; *(f32x4*)(P->out + O_SK + o) = kx[i]; *(f32x4*)(P->out + O_SV + o) = vx[i]; } }
      if (tid < 256) { const int r = tid >> 6, d = tid & 63; const bf16_t* rp = Z2 + (size_t)(row0 + r) * 512 + kvh * 64 + d; const float kv = bf2f(rp[0]), vv = bf2f(rp[256]);
          sK[(128 + r) * KP + d] = kv; sV[(128 + r) * KP + d] = vv; const size_t o = ((size_t)(b * 128 + 124 + r) * 4 + kvh) * 64 + d; P->out[O_SK + o] = kv; P->out[O_SV + o] = vv; } }
#pragma unroll
    for (int i = 0; i < 2; ++i) { const int id = tid + 512 * i, pair = id >> 6, d = id & 63, t = pair >> 2, g = pair & 3; sQ[id] = bf2f(Z1[(size_t)(row0 + t) * 2048 + 1024 + (4 * kvh + g) * 64 + d]); }
    __syncthreads();
    for (int id = tid; id < 16 * 132; id += 512) { const int pair = id / 132, idx = id % 132, t = pair >> 2, g = pair & 3, delta = 128 + t - idx;
        float s = -INFINITY;
        if (delta >= 0 && delta < 128) { float a = 0.f;
#pragma unroll
            for (int cc = 0; cc < 16; ++cc) { const f32x4 q = *(const f32x4*)(sQ + pair * 64 + 4 * cc), k = *(const f32x4*)(sK + idx * KP + 4 * cc); a += (q[0] * k[0] + q[1] * k[1]) + (q[2] * k[2] + q[3] * k[3]); }
            s = a - exp2f(-0.5f * (float)(4 * kvh + g + 1)) * (float)delta; }
        sP[id] = s; }
    __syncthreads();
#pragma unroll
    for (int pp = 0; pp < 2; ++pp) { const int pair = 2 * c.wave + pp, g = pair & 3; const float sink = P->sinks[4 * kvh + g];
        float x[3], mx = sink;
#pragma unroll
        for (int i = 0; i < 3; ++i) { const int idx = c.lane + 64 * i; x[i] = idx < 132 ? sP[pair * 132 + idx] : -INFINITY; mx = fmaxf(mx, x[i]); }
        mx = wave_max(mx); float sum = 0.f;
#pragma unroll
        for (int i = 0; i < 3; ++i) { x[i] = __expf(x[i] - mx); sum += x[i]; }
        const float inv = 1.f / (wave_sum(sum) + __expf(sink - mx));
#pragma unroll
        for (int i = 0; i < 3; ++i) { const int idx = c.lane + 64 * i; if (idx < 132) sP[pair * 132 + idx] = x[i] * inv; } }
    __syncthreads();
    {
        const int pair = tid >> 5, hf = (tid >> 4) & 1, d4 = tid & 15, t = pair >> 2, g = pair & 3;
        f32x4 o = (f32x4){0.f, 0.f, 0.f, 0.f};
#pragma unroll 6
        for (int i = 0; i < 66; ++i) { const int idx = 66 * hf + i; o = o + *(const f32x4*)(sV + idx * KP + 4 * d4) * sP[pair * 132 + idx]; }
#pragma unroll
        for (int e = 0; e < 4; ++e) o[e] += __shfl_xor(o[e], 16);
        if (hf == 0) { u32x2 w; w.x = pk2(o[0], o[1]); w.y = pk2(o[2], o[3]); *(u32x2*)(Z1 + (size_t)(row0 + t) * 2048 + 1024 + (4 * kvh + g) * 64 + 4 * d4) = w; } }
    __syncthreads();
}

__device__ __forceinline__ void phase3(PP P, unsigned char* lds, const Ctx& c) {
    { const bf16_t* Z2 = (const bf16_t*)(P->ws + WS_Z2);
      for (int i = blockIdx.x * 512 + c.tid; i < 2 * 128 * 512; i += gridDim.x * 512) { const int cc = i & 511, r = (i >> 9) & 127, b = i >> 16;
          const float v = bf2f(Z2[(size_t)(b * SEQ + SEQ - 128 + r) * 512 + cc]);
          if (cc < 256) P->out[O_PK + (size_t)(b * 128 + r) * 256 + cc] = v; else P->out[O_PV + (size_t)(b * 128 + r) * 256 + cc - 256] = v; } }
    if ((blockIdx.x >> 3) & 1) {
        for (int u = blockIdx.x; u < 512; u += gridDim.x) mlstm_sample_unit(P, lds, c, u);
        for (int u = blockIdx.x; u < 512; u += gridDim.x) swa_sample_unit(P, lds, c, u);
        for (int u = blockIdx.x; u < 512; u += gridDim.x) mlstm_local_unit(P, lds, c, u);
        for (int u = blockIdx.x; u < 1024; u += gridDim.x) swa_prompt_unit(P, lds, c, u);
    } else {
        for (int u = blockIdx.x; u < 512; u += gridDim.x) mlstm_local_unit(P, lds, c, u);
        for (int u = blockIdx.x; u < 1024; u += gridDim.x) swa_prompt_unit(P, lds, c, u);
        for (int u = blockIdx.x; u < 512; u += gridDim.x) mlstm_sample_unit(P, lds, c, u);
        for (int u = blockIdx.x; u < 512; u += gridDim.x) swa_sample_unit(P, lds, c, u);
    }
}

__device__ __forceinline__ void phase4(PP P, unsigned char* lds, const Ctx& c) {
    float* sal = (float*)lds; float* sbe = sal + 64;
    const float* chs = (const float*)(P->ws + WS_MISC + MISC_CH); float* mc = (float*)(P->ws + WS_MISC + MISC_MC); float* un = (float*)(P->ws + WS_MISC + MISC_UN);
    for (int vb = blockIdx.x; vb < 256; vb += gridDim.x) {
        const int bh = vb >> 5, part = vb & 31;
        __syncthreads();
        if (c.tid < 128) sbe[64 + c.tid] = chs[bh * 128 + c.tid];
        __syncthreads();
        if (c.tid == 0) { float m = 0.f;
            for (int ch = 0; ch < 64; ++ch) { sbe[192 + ch] = m; m = sbe[64 + 2 * ch] + fmaxf(m, sbe[65 + 2 * ch]); }
            sbe[256] = m; }
        __syncthreads();
        if (c.tid < 64) { const float m = sbe[192 + c.tid], AT = sbe[65 + 2 * c.tid], Mc = fmaxf(m, AT); sal[c.tid] = __expf(m - Mc); sbe[c.tid] = __expf(AT - Mc); if (part == 0) mc[bh * 65 + c.tid] = m; }
        if (c.tid == 64 && part == 0) { const float m = sbe[256]; mc[bh * 65 + 64] = m; P->out[O_PM + bh] = m; }
        __syncthreads();
        { const int e = part * 1024 + 2 * c.tid; unsigned* U = (unsigned*)((bf16_t*)P->out + (size_t)bh * 64 * 32768 + e); f32x2 C = (f32x2){0.f, 0.f};
#pragma unroll 16
          for (int ch = 0; ch < 64; ++ch) { unsigned* p = U + (size_t)ch * 16384; const unsigned u = *p; *p = pk2(C[0], C[1]); C[0] = C[0] * sal[ch] + lo16(u) * sbe[ch]; C[1] = C[1] * sal[ch] + hi16(u) * sbe[ch]; }
          *(f32x2*)(P->out + O_PC + (size_t)bh * 32768 + e) = C; }
        if (part == 0 && c.tid < 128) { float n = 0.f; float uu[64];
#pragma unroll
            for (int ch = 0; ch < 64; ++ch) uu[ch] = un[(size_t)(bh * 64 + ch) * 128 + c.tid];
#pragma unroll
            for (int ch = 0; ch < 64; ++ch) { un[(size_t)(bh * 64 + ch) * 128 + c.tid] = n; n = n * sal[ch] + uu[ch] * sbe[ch]; }
            P->out[O_PN + bh * 128 + c.tid] = n; }
    }
}

__device__ __forceinline__ void mlstm_out_unit(PP P, unsigned char* lds, const Ctx& c, int unit) {
    const int bh = unit >> 6, ch = unit & 63, b = bh >> 2, h = bh & 3, row0 = b * SEQ + ch * 128, tid = c.tid;
    bf16_t* Ql = (bf16_t*)lds; bf16_t* Kl = (bf16_t*)(lds + 128 * LP * 2); bf16_t* Cl = (bf16_t*)(lds + 256 * LP * 2);
    float* sm = (float*)(lds + 512 * LP * 2);
    float* sMt = sm + 640; float* sain = sMt + 128; float* seinv = sain + 128; float* sdinv = seinv + 128; float* sn = sdinv + 128; float* spart = sn + 128;
    const bf16_t* Z0 = (const bf16_t*)(P->ws + WS_Z0); bf16_t* Z1 = (bf16_t*)(P->ws + WS_Z1); const bf16_t* Z3 = (const bf16_t*)(P->ws + WS_Z3);
    u32x4 rq[4], rk[4], rc[8];
#pragma unroll
    for (int i = 0; i < 4; ++i) { const int id = tid + 512 * i, t = id >> 4, c8 = id & 15; const bf16_t* rp = Z0 + (size_t)(row0 + t) * 1024 + 128 * h + 8 * c8; rq[i] = *(const u32x4*)rp; rk[i] = *(const u32x4*)(rp + 512); }
    { const bf16_t* Cs = (const bf16_t*)P->out + (size_t)(bh * 64 + ch) * 32768;
#pragma unroll
      for (int i = 0; i < 8; ++i) { const int id = tid + 512 * i, v = id >> 4, c8 = id & 15; rc[i] = *(const u32x4*)(Cs + v * 128 + 8 * c8); } }
    chunk_gates(P, sm, row0, h, c);
    const float mcv = ((const float*)(P->ws + WS_MISC + MISC_MC))[bh * 65 + ch];
    if (tid < 128) { const float Mt = fmaxf(mcv, sm[512 + tid]); sMt[tid] = Mt; sain[tid] = __expf(mcv - Mt); seinv[tid] = __expf(-(sm[256 + tid] + Mt));
        sn[tid] = ((const float*)(P->ws + WS_MISC + MISC_UN))[(size_t)(bh * 64 + ch) * 128 + tid]; }
#pragma unroll
    for (int i = 0; i < 4; ++i) { const int id = tid + 512 * i, t = id >> 4, c8 = id & 15; *(u32x4*)(Ql + t * LP + 8 * c8) = rq[i]; *(u32x4*)(Kl + t * LP + 8 * c8) = rk[i]; }
#pragma unroll
    for (int i = 0; i < 8; ++i) { const int id = tid + 512 * i, v = id >> 4, c8 = id & 15; *(u32x4*)(Cl + v * LP + 8 * c8) = rc[i]; }
    __syncthreads();
    const int ql = c.lane & 31, hh = c.lane >> 5;
    { const int sb = c.wave & 3, th = c.wave >> 2;
      f32x16 sacc[2];
#pragma unroll
      for (int j = 0; j < 2; ++j) {
#pragma unroll
          for (int r = 0; r < 16; ++r) sacc[j][r] = 0.f;
          const int tt = 2 * th + j;
          if (tt >= sb) {
#pragma unroll
              for (int ks = 0; ks < 8; ++ks) { const bf16x8 a = *(const bf16x8*)(Kl + (32 * sb + ql) * LP + 16 * ks + 8 * hh), bq = *(const bf16x8*)(Ql + (32 * tt + ql) * LP + 16 * ks + 8 * hh);
                  sacc[j] = __builtin_amdgcn_mfma_f32_32x32x16_bf16(a, bq, sacc[j], 0, 0, 0); } } }
      __syncthreads();
#pragma unroll
      for (int j = 0; j < 2; ++j) { const int t = 32 * (2 * th + j) + ql; const float Mt = sMt[t];
#pragma unroll
          for (int g4 = 0; g4 < 4; ++g4) { float v[4];
#pragma unroll
              for (int e = 0; e < 4; ++e) { const int s = 32 * sb + 8 * g4 + 4 * hh + e; v[e] = (s <= t) ? sacc[j][4 * g4 + e] * __expf(sm[384 + s] - Mt) : 0.f; }
              u32x2 w; w.x = pk2(v[0], v[1]); w.y = pk2(v[2], v[3]); *(u32x2*)(Kl + t * LP + 32 * sb + 8 * g4 + 4 * hh) = w; } } }
    __syncthreads();
    { const int t = tid >> 2, part = tid & 3; float ss = 0.f, nq = 0.f;
      for (int i = 0; i < 32; ++i) { ss += bf2f(Kl[t * LP + 32 * part + i]); nq += bf2f(Ql[t * LP + 32 * part + i]) * sn[32 * part + i]; }
      ss += __shfl_xor(ss, 1); ss += __shfl_xor(ss, 2); nq += __shfl_xor(nq, 1); nq += __shfl_xor(nq, 2);
      if (part == 0) sdinv[t] = 1.f / fmaxf(fabsf(ss + sain[t] * nq), seinv[t]); }
    const int tb = c.wave & 3, vh = c.wave >> 2;
    f32x16 acc[4];
#pragma unroll
    for (int i = 0; i < 4; ++i)
#pragma unroll
        for (int r = 0; r < 16; ++r) acc[i][r] = 0.f;
#pragma unroll
    for (int ks = 0; ks < 8; ++ks) { const bf16x8 bq = *(const bf16x8*)(Ql + (32 * tb + ql) * LP + 16 * ks + 8 * hh);
#pragma unroll
        for (int i = 0; i < 4; ++i) { const bf16x8 a = *(const bf16x8*)(Cl + (32 * (4 * vh + i) + ql) * LP + 16 * ks + 8 * hh); acc[i] = __builtin_amdgcn_mfma_f32_32x32x16_bf16(a, bq, acc[i], 0, 0, 0); } }
    { const float ai = sain[32 * tb + ql];
#pragma unroll
      for (int i = 0; i < 4; ++i) acc[i] = acc[i] * ai; }
    __syncthreads();
#pragma unroll
    for (int i = 0; i < 8; ++i) { const int s = (c.lane >> 1) + 32 * (i & 3), c8 = 4 * c.wave + 2 * (i >> 2) + (c.lane & 1); const u32x4 x = *(const u32x4*)(Z1 + (size_t)(row0 + s) * 2048 + 256 * h + 8 * c8);
#pragma unroll
        for (int q = 0; q < 4; ++q) { Cl[(8 * c8 + 2 * q) * LP + s] = (bf16_t)(x[q] & 0xffffu); Cl[(8 * c8 + 2 * q + 1) * LP + s] = (bf16_t)(x[q] >> 16); } }
    __syncthreads();
    for (int ks = 0; ks < 2 * (tb + 1); ++ks) { const bf16x8 bs = *(const bf16x8*)(Kl + (32 * tb + ql) * LP + 16 * ks + 8 * hh);
#pragma unroll
        for (int i = 0; i < 4; ++i) { const bf16x8 a = *(const bf16x8*)(Cl + (32 * (4 * vh + i) + ql) * LP + 16 * ks + 8 * hh); acc[i] = __builtin_amdgcn_mfma_f32_32x32x16_bf16(a, bs, acc[i], 0, 0, 0); } }
    const int t = 32 * tb + ql; const float dinv = sdinv[t];
    float s1 = 0.f, s2 = 0.f;
#pragma unroll
    for (int i = 0; i < 4; ++i)
#pragma unroll
        for (int r = 0; r < 16; ++r) { const float x = acc[i][r] * dinv; acc[i][r] = x; s1 += x; s2 += x * x; }
    s1 += __shfl_xor(s1, 32); s2 += __shfl_xor(s2, 32);
    if (hh == 0) { spart[(vh * 128 + t) * 2] = s1; spart[(vh * 128 + t) * 2 + 1] = s2; }
    __syncthreads();
    const float mean = (spart[t * 2] + spart[(128 + t) * 2]) * (1.f / 256.f), ex2 = (spart[t * 2 + 1] + spart[(128 + t) * 2 + 1]) * (1.f / 256.f);
    const float rstd = 1.f / sqrtf(fmaxf(ex2 - mean * mean, 0.f) + LN_EPS);
    bf16_t* Tl = (bf16_t*)lds; constexpr int TP = 264;
#pragma unroll
    for (int i = 0; i < 4; ++i)
#pragma unroll
        for (int g4 = 0; g4 < 4; ++g4) { const int v0 = 32 * (4 * vh + i) + 8 * g4 + 4 * hh; u32x2 w;
            w.x = pk2((acc[i][4 * g4] - mean) * rstd, (acc[i][4 * g4 + 1] - mean) * rstd); w.y = pk2((acc[i][4 * g4 + 2] - mean) * rstd, (acc[i][4 * g4 + 3] - mean) * rstd);
            *(u32x2*)(Tl + t * TP + v0) = w; }
    __syncthreads();
#pragma unroll
    for (int k = 0; k < 8; ++k) { const int id = tid + 512 * k, t2 = id >> 5, ch = id & 31, vc = 256 * h + 8 * ch;
        const u32x4 x = *(const u32x4*)(Tl + t2 * TP + 8 * ch), og = *(const u32x4*)(Z3 + (size_t)(row0 + t2) * 1024 + vc);
        const f32x4 n0 = *(const f32x4*)(P->mnorm + vc), n1 = *(const f32x4*)(P->mnorm + vc + 4);
        u32x4 w;
        w.x = pk2(lo16(x.x) * n0[0] * lo16(og.x), hi16(x.x) * n0[1] * hi16(og.x));
        w.y = pk2(lo16(x.y) * n0[2] * lo16(og.y), hi16(x.y) * n0[3] * hi16(og.y));
        w.z = pk2(lo16(x.z) * n1[0] * lo16(og.z), hi16(x.z) * n1[1] * hi16(og.z));
        w.w = pk2(lo16(x.w) * n1[2] * lo16(og.w), hi16(x.w) * n1[3] * hi16(og.w));
        *(u32x4*)(Z1 + (size_t)(row0 + t2) * 2048 + vc) = w; }
    __syncthreads();
}

template <int NH>
__device__ __forceinline__ void small_gemm_tile(const bf16_t* A, int lda, const bf16_t* Bt, int ldb, int KH, int row0, int col0, unsigned char* lds, const Ctx& c, float (&res)[NH][4]) {
    const int ql = c.lane & 31, hh = c.lane >> 5, kw = KH >> 3, nks = kw >> 4;
    float* red = (float*)lds;
    f32x16 acc[NH][2];
#pragma unroll
    for (int h = 0; h < NH; ++h)
#pragma unroll
        for (int ct = 0; ct < 2; ++ct)
#pragma unroll
            for (int r = 0; r < 16; ++r) acc[h][ct][r] = 0.f;
    const bf16_t* ap = A + (size_t)(row0 + ql) * lda + c.wave * kw + 8 * hh;
    const bf16_t* bp0 = Bt + (size_t)(col0 + ql) * ldb + c.wave * kw + 8 * hh;
    const bf16_t* bp1 = bp0 + (size_t)32 * ldb;
#pragma unroll
    for (int h = 0; h < NH; ++h) {
#pragma unroll 4
        for (int ks = 0; ks < nks; ++ks) { const int k = h * KH + 16 * ks;
            const bf16x8 a = *(const bf16x8*)(ap + k), b0 = *(const bf16x8*)(bp0 + k), b1 = *(const bf16x8*)(bp1 + k);
            acc[h][0] = __builtin_amdgcn_mfma_f32_32x32x16_bf16(a, b0, acc[h][0], 0, 0, 0);
            acc[h][1] = __builtin_amdgcn_mfma_f32_32x32x16_bf16(a, b1, acc[h][1], 0, 0, 0); } }
#pragma unroll
    for (int h = 0; h < NH; ++h)
#pragma unroll
        for (int ct = 0; ct < 2; ++ct)
#pragma unroll
            for (int r = 0; r < 16; ++r) red[(((h * 8 + c.wave) * 2 + ct) * 16 + r) * 64 + c.lane] = acc[h][ct][r];
    __syncthreads();
#pragma unroll
    for (int h = 0; h < NH; ++h)
#pragma unroll
        for (int j = 0; j < 4; ++j) { const int e = c.tid + 512 * j, row = e >> 6, col = e & 63, ct = col >> 5, l2 = (col & 31) + 32 * ((row >> 2) & 1), r = (row & 3) + 4 * (row >> 3);
            float s = 0.f;
#pragma unroll
            for (int w = 0; w < 8; ++w) s += red[(((h * 8 + w) * 2 + ct) * 16 + r) * 64 + l2];
            res[h][j] = s; }
    __syncthreads();
}
__device__ __forceinline__ void tail_branch(PP P, unsigned char* lds, const Ctx& c) {
    const bf16_t* Z1 = (const bf16_t*)(P->ws + WS_Z1); const bf16_t* Z4 = (const bf16_t*)(P->ws + WS_Z4); bf16_t* O = (bf16_t*)(P->ws + WS_Z0);
    for (int t = blockIdx.x; t < 256; t += gridDim.x) { const int row0 = MP + (t >> 4) * 32, col0 = (t & 15) * 64;
        float res[2][4];
        small_gemm_tile<2>(Z1, 2048, (const bf16_t*)(P->ws + WS_WBR), 2048, 1024, row0, col0, lds, c, res);
#pragma unroll
        for (int j = 0; j < 4; ++j) { const int e = c.tid + 512 * j, row = row0 + (e >> 6), col = col0 + (e & 63);
            const float gm = bf2f(Z4[(size_t)row * 2048 + col]), ga = bf2f(Z4[(size_t)row * 2048 + 1024 + col]);
            O[(size_t)row * 1024 + col] = (bf16_t)f2bf(gm * res[0][j] + ga * res[1][j]); } }
}
__device__ __forceinline__ void tail_res(PP P, unsigned char* lds, const Ctx& c, const bf16_t* A, int lda, const bf16_t* Bt, int K, int goff, const float* bias, int inplace) {
    const float* mod = (const float*)(P->ws + WS_MOD);
    for (int t = blockIdx.x; t < 256; t += gridDim.x) { const int row0 = MP + (t >> 4) * 32, col0 = (t & 15) * 64;
        float res[1][4];
        small_gemm_tile<1>(A, lda, Bt, K, K, row0, col0, lds, c, res);
#pragma unroll
        for (int j = 0; j < 4; ++j) { const int e = c.tid + 512 * j, row = row0 + (e >> 6), col = col0 + (e & 63);
            const float g = mod[(size_t)seq_of_row(row) * 6144 + goff + col];
            float a = res[0][j]; if (bias) a += bias[col];
            if (inplace) P->out[(size_t)row * 1024 + col] = ALPHA * bf2f(((const bf16_t*)(P->ws + WS_X1))[(size_t)row * 1024 + col]) + g * a;
            else ((bf16_t*)(P->ws + WS_XP))[(size_t)row * 1024 + col] = (bf16_t)f2bf(ALPHA * P->x_s[(size_t)(row - MP) * 1024 + col] + g * a); } }
}

__device__ __forceinline__ void fixup_rows(PP P, const Ctx& c, int pm) {
    const bf16_t* UB = (const bf16_t*)(P->ws + WS_UB); bf16_t* ACT = (bf16_t*)(P->ws + WS_ACT); const bool first = (pm & 31) == 0;
#pragma unroll 3
    for (int k = 0; k < 6; ++k) { const int f = c.tid + 512 * k;
        if (f < DFF) {
            float ua[4], ug[4];
#pragma unroll
            for (int s = 0; s < 4; ++s) { ua[s] = bf2f(UB[((size_t)pm * 4 + s) * F2 + f]); ug[s] = bf2f(UB[((size_t)pm * 4 + s) * F2 + DFF + f]); }
            if (first) { ua[0] = 0.f; ua[1] = 0.f; ug[0] = 0.f; ug[1] = 0.f; }
            const float cba = P->conv_b[f], cbg = P->conv_b[DFF + f];
            const float wa0 = P->conv_w[f], wa1 = P->conv_w[F2 + f], wa2 = P->conv_w[2 * F2 + f];
            const float wg0 = P->conv_w[DFF + f], wg1 = P->conv_w[F2 + DFF + f], wg2 = P->conv_w[2 * F2 + DFF + f];
#pragma unroll
            for (int rr = 0; rr < 2; ++rr) { const float av = cba + wa0 * ua[rr] + wa1 * ua[rr + 1] + wa2 * ua[rr + 2], gv = cbg + wg0 * ug[rr] + wg1 * ug[rr + 1] + wg2 * ug[rr + 2];
                ACT[(size_t)(pm * 256 + rr) * DFF + f] = (bf16_t)f2bf(gelu_tanh(av) * gv); } } }
}
__device__ __forceinline__ void pconv_out(PP P, const Ctx& c) {
    const bf16_t* UB = (const bf16_t*)(P->ws + WS_UB);
    for (int i = blockIdx.x * 512 + c.tid; i < 2 * 2 * F2; i += gridDim.x * 512) { const int col = i % F2, r = (i / F2) & 1, b = i / (2 * F2); P->out[O_PCONV + i] = bf2f(UB[((size_t)(32 * (b + 1)) * 4 + r) * F2 + col]); }
}

#define XB_TMO      128
#define XB_XCNT(j)  (256  + 64 * (j))
#define XB_XSUB(j)  (1280 + 64 * (j))
#define XB_XGEN(j)  (2304 + 64 * (j))
#define XB_TOP      3328
#define XB_TOPGEN   3392
#define XCD_BAR_WORDS 3456
#define XB_SPIN_CAP (1u << 22)
__device__ __forceinline__ unsigned xb_ld(unsigned* p)              { return __hip_atomic_load(p, __ATOMIC_RELAXED, __HIP_MEMORY_SCOPE_AGENT); }
__device__ __forceinline__ unsigned xb_add(unsigned* p, unsigned v) { return __hip_atomic_fetch_add(p, v, __ATOMIC_RELAXED, __HIP_MEMORY_SCOPE_AGENT); }
__device__ __forceinline__ unsigned xb_xcc_id() { return (unsigned)__builtin_amdgcn_s_getreg((3 << 11) | 20) & 0xFu; }
#define XB_SPIN(cond, bar) do { unsigned _sp = 0; while (cond) { __builtin_amdgcn_s_sleep(1); \
    if ((++_sp & 255u) == 0u) { if (xb_ld(&(bar)[XB_TMO])) break; if (_sp > XB_SPIN_CAP) { atomicAdd(&(bar)[XB_TMO], 1u); break; } } } } while (0)
struct XcdBarrier { unsigned* bar; unsigned x; volatile LAS unsigned* st; };
__device__ __forceinline__ XcdBarrier xcd_barrier_post(unsigned* bar, volatile LAS unsigned* st) {
    XcdBarrier b; b.bar = bar; b.x = xb_xcc_id(); b.st = st;
    if (threadIdx.x == 0) (void)xb_add(&bar[XB_XCNT(b.x)], 1u);
    return b;
}
__device__ __forceinline__ void xcd_barrier_complete(unsigned* bar, unsigned x, unsigned& nloc, unsigned& nx) {
    const unsigned G = gridDim.x * gridDim.y * gridDim.z;
    unsigned sum, cnt, mine, sp = 0u;
    for (;;) {
        sum = 0u; cnt = 0u; mine = 0u;
#pragma unroll
        for (unsigned j = 0; j < 16; ++j) { const unsigned c = xb_ld(&bar[XB_XCNT(j)]); sum += c; cnt += (c > 0u) ? 1u : 0u; mine = (j == x) ? c : mine; }
        if (sum == G) break;
        __builtin_amdgcn_s_sleep(1);
        if ((++sp & 255u) == 0u) { if (xb_ld(&bar[XB_TMO])) break; if (sp > XB_SPIN_CAP) { atomicAdd(&bar[XB_TMO], 1u); break; } }
    }
    nloc = mine > 0u ? mine : 1u; nx = cnt > 0u ? cnt : 1u;
}
__device__ __forceinline__ void xcd_barrier(const XcdBarrier& b) {
    asm volatile("s_waitcnt vmcnt(0)" ::: "memory");
    __syncthreads();
    if (threadIdx.x == 0) {
        unsigned* bar = b.bar;
        __builtin_amdgcn_s_waitcnt(0);
        unsigned nloc = b.st[0], nx = b.st[1];
        if (nloc == 0u) { xcd_barrier_complete(bar, b.x, nloc, nx); b.st[0] = nloc; b.st[1] = nx; }
        const unsigned old = xb_add(&bar[XB_XSUB(b.x)], 1u);
        const unsigned gen = old / nloc;
        if (old + 1u == (gen + 1u) * nloc) {
            __builtin_amdgcn_fence(__ATOMIC_RELEASE, "agent");
            asm volatile("s_waitcnt vmcnt(0)" ::: "memory");
            const unsigned og = xb_add(&bar[XB_TOP], 1u);
            const unsigned tg = og / nx;
            if (og + 1u == (tg + 1u) * nx) xb_add(&bar[XB_TOPGEN], 1u);
            else XB_SPIN(xb_ld(&bar[XB_TOPGEN]) == tg, bar);
            __builtin_amdgcn_fence(__ATOMIC_ACQUIRE, "agent");
            xb_add(&bar[XB_XGEN(b.x)], 1u);
            asm volatile("s_waitcnt vmcnt(0)" ::: "memory");
        } else {
            XB_SPIN(xb_ld(&bar[XB_XGEN(b.x)]) == gen, bar);
            __builtin_amdgcn_fence(__ATOMIC_ACQUIRE, "agent");
            asm volatile("s_waitcnt vmcnt(0)" ::: "memory");
        }
    }
    __syncthreads();
}

__global__ void __launch_bounds__(512, 2) fwd_megakernel(Params Pk) {
    extern __shared__ __attribute__((aligned(16))) unsigned char lds[];
    cg::grid_group grid = cg::this_grid();
    Ctx c;
#define MKCTX() do { int t_ = threadIdx.x; asm volatile("" : "+v"(t_)); c.tid = t_; c.lane = t_ & 63; c.wave = __builtin_amdgcn_readfirstlane(t_ >> 6); c.vw = c.wave * gridDim.x + blockIdx.x; c.nvw = 8 * gridDim.x; } while (0)
    MKCTX();
    LAS unsigned char* ldsl = (LAS unsigned char*)lds;
    const int G = gridDim.x, bid = blockIdx.x;
    PP P = (PP)__builtin_amdgcn_kernarg_segment_ptr();
    if (threadIdx.x < 2) ((volatile LAS unsigned*)(ldsl + LDS_BAR_OFF))[threadIdx.x] = 0u;
    __syncthreads();
    if (blockIdx.x == 0) { unsigned* zb = (unsigned*)(P->ws + WS_BAR); for (int i = threadIdx.x; i < 8192; i += 512) zb[i] = 0u; }
#define LAUNDER() asm volatile("" : "+s"(P))
#define HS ((bf16_t*)(P->out + O_SC))
#define HB ((bf16_t*)(P->ws + WS_Z0))

    if constexpr (PH_MASK & 1) phase0(P, lds, c);
    grid.sync(); LAUNDER(); MKCTX();
    XcdBarrier xbar = xcd_barrier_post((unsigned*)(P->ws + WS_BAR), (volatile LAS unsigned*)(ldsl + LDS_BAR_OFF));
    if constexpr (PH_MASK & 2) phase1(P, c, HS);
    xcd_barrier(xbar); LAUNDER(); MKCTX();
    if constexpr (PH_MASK & 4) { pg8::Gemm g{HS, (const bf16_t*)(P->ws + WS_W1T), MT, N1, 1024, 1024, 1024}; pg8::StaticOrder S; S.init(MT, N1, G, bid);
      EpiZ E{P->ws, (const float*)(P->ws + WS_MISC + MISC_BIASZ)}; pg8::gemm_phase<EpiZ>(ldsl, g, S, E);
      { const int nfull = (MT / 256) * (N1 / 256) % G; if (nfull != 0 && bid >= nfull) { MKCTX(); late_copies_a(P, lds, c, (bid - nfull) * 8 + c.wave, (G - nfull) * 8); }
        else if (nfull == 0) { MKCTX(); late_copies_a(P, lds, c, bid * 8 + c.wave, G * 8); } } }
    xcd_barrier(xbar); LAUNDER(); MKCTX();
    if constexpr (PH_MASK & 8) phase3(P, lds, c);
    xcd_barrier(xbar); LAUNDER(); MKCTX();
    if constexpr (PH_MASK & 16) phase4(P, lds, c);
    xcd_barrier(xbar); LAUNDER(); MKCTX();
    if constexpr (PH_MASK & 32) for (int u = bid; u < 512; u += G) mlstm_out_unit(P, lds, c, u);
    xcd_barrier(xbar); LAUNDER(); MKCTX();
    if constexpr (PH_MASK & 64) { pg8::Gemm g{(const bf16_t*)(P->ws + WS_Z1), (const bf16_t*)(P->ws + WS_WBR), MT, 1024, 2048, 2048, 2048}; pg8::StaticOrder S; S.init(MP, 1024, G, bid);
      EpiBranch E{(const bf16_t*)(P->ws + WS_Z4), HB}; pg8::gemm_phase<EpiBranch>(ldsl, g, S, E); MKCTX(); tail_branch(P, lds, c); }
    xcd_barrier(xbar); LAUNDER(); MKCTX();
    if constexpr (PH_MASK & 128) { pg8::Gemm g{HB, (const bf16_t*)(P->ws + WS_WOT), MT, 1024, 1024, 1024, 1024}; pg8::StaticOrder S; S.init(MP, 1024, G, bid);
      EpiRes E{P->x_p, P->x_s, (const float*)(P->ws + WS_MOD), 2048, (bf16_t*)(P->ws + WS_XP)}; pg8::gemm_phase<EpiRes>(ldsl, g, S, E); MKCTX();
      tail_res(P, lds, c, HB, 1024, (const bf16_t*)(P->ws + WS_WOT), 1024, 2048, nullptr, 0); }
    xcd_barrier(xbar); LAUNDER(); MKCTX();
    if constexpr (PH_MASK & 256) phase8(P, c, HB);
    xcd_barrier(xbar); LAUNDER(); MKCTX();
    if constexpr (PH_MASK & 512) { pg8::Gemm g{HB, (const bf16_t*)(P->ws + WS_WUT), MT, F2, 1024, 1024, 1024}; pg8::StaticOrder S; S.init(MT, F2, G, bid);
      EpiUp E{P->b_up, P->conv_w, P->conv_b, (bf16_t*)(P->ws + WS_SCR) + (size_t)bid * 65536, (bf16_t*)(P->ws + WS_UB), (bf16_t*)(P->ws + WS_US), (bf16_t*)(P->ws + WS_ACT), P->st_conv, P->out + O_SCONV};
      pg8::gemm_phase<EpiUp>(ldsl, g, S, E);
      { const int nfull = (MT / 256) * (F2 / 256) % G; if (nfull != 0 && bid >= nfull) { MKCTX(); late_copies_b(P, lds, c, (bid - nfull) * 8 + c.wave, (G - nfull) * 8); }
        else if (nfull == 0) { MKCTX(); late_copies_b(P, lds, c, bid * 8 + c.wave, G * 8); } } }
    xcd_barrier(xbar); LAUNDER(); MKCTX();
    if constexpr (PH_MASK & 2048) { pg8::Gemm g{(const bf16_t*)(P->ws + WS_ACT), (const bf16_t*)(P->ws + WS_WDT), MT, 1024, DFF, DFF, DFF}; pg8::StaticOrder S; S.init(MP, 1024, G, bid);
      { pg8::Unit u0; if (S.next(0, u0)) fixup_rows(P, c, u0.pm); asm volatile("s_waitcnt vmcnt(0)" ::: "memory"); __syncthreads(); }
      EpiDownLn E{(const float*)(P->ws + WS_MOD), P->b_down, P->ln2g, P->ln2b, P->out, (const bf16_t*)(P->ws + WS_X1), (unsigned long long*)(P->ws + WS_XBUF), (unsigned*)(P->ws + WS_CNT)}; pg8::gemm_phase<EpiDownLn>(ldsl, g, S, E); MKCTX();
      tail_res(P, lds, c, (const bf16_t*)(P->ws + WS_ACT), DFF, (const bf16_t*)(P->ws + WS_WDT), DFF, 5120, P->b_down, 1); }
    xcd_barrier(xbar); LAUNDER(); MKCTX();
    if constexpr (PH_MASK & 4096) { phase12(P, c); pconv_out(P, c); }
}
#undef LAUNDER
#undef MKCTX
#undef HS
#undef HB

extern "C" void kernel_launch(void* const* d_in, const int* in_sizes, int n_in, void* d_out, int out_size, void* d_ws, size_t ws_size, hipStream_t stream) {
    static int grid_blocks = 0;
    if (grid_blocks == 0) {
        int dev = 0, cus = 0, per_cu = 0;
        hipGetDevice(&dev);
        hipDeviceGetAttribute(&cus, hipDeviceAttributeMultiprocessorCount, dev);
        hipFuncSetAttribute((const void*)fwd_megakernel, hipFuncAttributeMaxDynamicSharedMemorySize, LDS_BYTES);
        hipOccupancyMaxActiveBlocksPerMultiprocessor(&per_cu, (const void*)fwd_megakernel, 512, LDS_BYTES);
        if (per_cu < 1) { fprintf(stderr, "occupancy query reports %d blocks/CU\n", per_cu); per_cu = 1; }
        if (per_cu > 1) per_cu = 1;
        grid_blocks = cus * per_cu;
        if (grid_blocks > 256) grid_blocks = 256;
        if (n_in != 29 || ws_size < 256 * MiB) fprintf(stderr, "kernel_launch: unexpected n_in %d / ws_size %zu\n", n_in, ws_size);
    }
    Params p{};
    const float** pp = (const float**)&p;
    for (int i = 0; i < 29; ++i) pp[i] = (const float*)d_in[i];
    p.out = (float*)d_out; p.ws = (unsigned char*)d_ws;
    void* args[] = {&p};
    hipError_t e = hipLaunchCooperativeKernel((const void*)fwd_megakernel, dim3(grid_blocks), dim3(512), args, LDS_BYTES, stream);
    if (e != hipSuccess) fprintf(stderr, "cooperative launch failed: %s (grid %d)\n", hipGetErrorString(e), grid_blocks);
}
```

```cpp
#include <hip/hip_runtime.h>
#include <hip/hip_cooperative_groups.h>
#include <cstdio>
#include <cstdint>
namespace cg = cooperative_groups;

typedef unsigned short bf16_t;
typedef short bf16x8 __attribute__((ext_vector_type(8)));
typedef float f32x4 __attribute__((ext_vector_type(4)));
typedef float f32x2 __attribute__((ext_vector_type(2)));
typedef float f32x16 __attribute__((ext_vector_type(16)));
typedef unsigned u32x4 __attribute__((ext_vector_type(4)));
typedef unsigned u32x2 __attribute__((ext_vector_type(2)));
#define LAS __attribute__((address_space(3)))

constexpr int D = 1024, SEQ = 8192, MP = 16384, MS = 512, MT = 16896, NSEQ = 130;
constexpr int N1 = 6656, DIN = 6664, F2 = 5632, DFF = 2816;
constexpr float LN_EPS = 1e-5f;
constexpr float ALPHA = 1.189207115002721f;
constexpr size_t O_Y = 0, O_PC = 17301504, O_PN = 17563648, O_PM = 17564672, O_PK = 17564680, O_PV = 17630216, O_PCONV = 17695752,
                 O_SC = 17718280, O_SN = 34495496, O_SM = 34561032, O_SK = 34561544, O_SV = 38755848, O_SCONV = 42950152;
constexpr size_t MiB = 1u << 20;
constexpr size_t WS_W1T = 0;
constexpr size_t WS_UB = 0;
constexpr size_t WS_US = 4 * MiB;
constexpr size_t WS_WBR = 13 * MiB;
constexpr size_t WS_WOT = 17 * MiB;
constexpr size_t WS_WUT = 19 * MiB;
constexpr size_t WS_WDT = 30 * MiB;
constexpr size_t WS_MOD = 35 * MiB + 512 * 1024;
constexpr size_t WS_GATES = 38 * MiB + 640 * 1024;
constexpr size_t WS_MISC = 39 * MiB + 256 * 1024;
static_assert(WS_MOD + 130 * 6144 * 4 <= WS_GATES && WS_GATES + 16896 * 8 * 4 <= WS_MISC && WS_MISC + 81920 + 8 * 64 * 128 * 4 <= 40 * MiB, "ws map");
constexpr size_t MISC_WG = 0;
constexpr size_t MISC_BIASZ = 32768;
constexpr size_t MISC_CH = 65536;
constexpr size_t MISC_MC = 65536 + 4096;
constexpr size_t MISC_UN = 81920;
constexpr size_t WS_Z0 = 40 * MiB;
constexpr size_t WS_Z1 = 73 * MiB;
constexpr size_t WS_Z2 = 139 * MiB;
constexpr size_t WS_Z3 = 155 * MiB + 512 * 1024;
constexpr size_t WS_Z4 = 188 * MiB + 512 * 1024;
constexpr size_t WS_XP = 73 * MiB;
constexpr size_t WS_X1 = 200 * MiB;
constexpr size_t WS_ACT = 73 * MiB;
constexpr size_t WS_SCR = 164 * MiB;
constexpr size_t WS_BAR = 39 * MiB + 640 * 1024;
constexpr size_t WS_CNT = WS_BAR + 16384;
constexpr size_t WS_XBUF = 254 * MiB + 512 * 1024;
constexpr int LDS_BAR_OFF = 147456 - 256;
constexpr int LDS_BYTES = 147456;
#ifndef PH_MASK
#define PH_MASK 0x1FFF
#endif

__device__ __forceinline__ float bf2f(bf16_t b) { return __uint_as_float(((unsigned)b) << 16); }
typedef __bf16 bf16x2_t __attribute__((ext_vector_type(2)));
__device__ __forceinline__ unsigned pk2(float lo, float hi) { const f32x2 v = {lo, hi}; const bf16x2_t b = __builtin_convertvector(v, bf16x2_t); return __builtin_bit_cast(unsigned, b); }
__device__ __forceinline__ unsigned f2bf(float f) { return pk2(f, 0.f) & 0xffffu; }
__device__ __forceinline__ float lo16(unsigned w) { return __uint_as_float(w << 16); }
__device__ __forceinline__ float hi16(unsigned w) { return __uint_as_float(w & 0xffff0000u); }
__device__ __forceinline__ float sigmoidf_(float x) { return __builtin_amdgcn_rcpf(1.f + __expf(-x)); }
__device__ __forceinline__ float wave_sum(float v) {
#pragma unroll
    for (int o = 1; o < 64; o <<= 1) v += __shfl_xor(v, o);
    return v;
}
__device__ __forceinline__ float wave_max(float v) {
#pragma unroll
    for (int o = 1; o < 64; o <<= 1) v = fmaxf(v, __shfl_xor(v, o));
    return v;
}
__device__ __forceinline__ float gelu_tanh(float x) { const float y = 0.7978845608028654f * (x + 0.044715f * x * x * x); return x * sigmoidf_(2.f * y); }

namespace pg8 {
constexpr int BM = 256, BK = 64, HALF = 128, HTB = HALF * BK * 2, STAGE_BYTES = 8 * HTB, NXCD = 8, WGM = 8;
__host__ __device__ __forceinline__ int lds_byte(int r, int c) { const int st = (r >> 4) * 2 + (c >> 5), rr = r & 15, cc = c & 31, ob = rr * 64 + cc * 2; return st * 1024 + (ob ^ (((ob >> 9) & 1) << 5)); }
__host__ __device__ __forceinline__ void stage_rc(int b, int& R, int& C) { const int st = b / 1024, sb = b % 1024, swz = sb ^ (((sb >> 9) & 1) << 5); R = (st >> 1) * 16 + swz / 64; C = (st & 1) * 32 + (swz % 64) / 2; }
__host__ __device__ __forceinline__ int perm32(int rho) { const int n = rho >> 4, i = rho & 15; return 8 * (i >> 2) + 4 * n + (i & 3); }
struct Unit { int pm, pn; };
struct Gemm { const bf16_t* A; const bf16_t* Bt; int M, N, K, lda, ldb; };
struct StaticOrder {
    int nM, nN, nwg, G, c;
    __host__ __device__ __forceinline__ void init(int M, int N, int G_, int c_) { nM = M / BM; nN = N / BM; nwg = nM * nN; G = G_; c = c_; }
    __host__ __device__ __forceinline__ bool next(int i, Unit& u) const {
        const long L = (long)i * G + c; if (L >= nwg) return false;
        int wgid = (int)L; { const int q = nwg / NXCD, r = nwg % NXCD, xcd = wgid % NXCD, off = wgid / NXCD; wgid = (xcd < r ? xcd * (q + 1) : r * (q + 1) + (xcd - r) * q) + off; }
        const int nig = WGM * nN, gid = wgid / nig, fm = gid * WGM, gsz = (nM - fm) < WGM ? (nM - fm) : WGM;
        u.pm = fm + ((wgid % nig) % gsz); u.pn = (wgid % nig) / gsz; return true;
    }
};
template <class Epi>
__device__ __forceinline__ void gemm_phase(LAS unsigned char* lds, const Gemm g, const StaticOrder& S, const Epi& E) {
    int tid_ = threadIdx.x; asm volatile("" : "+v"(tid_));
    const int tid = tid_, wid = __builtin_amdgcn_readfirstlane(tid >> 6), lane = tid & 63, wr = wid >> 2, wc = wid & 3, fr = lane & 15, fq = lane >> 4;
    const int K = g.K, nt = K / BK;
    unsigned voffA[2], voffB[2];
#pragma unroll
    for (int i = 0; i < 2; ++i) { int R, C; stage_rc(tid * 16 + i * 8192, R, C); const int Rb = Epi::PERM ? ((R & ~31) + perm32(R & 31)) : R;
        voffA[i] = (unsigned)(R * g.lda + C) * 2u; voffB[i] = (unsigned)(Rb * g.ldb + C) * 2u; }
    const size_t kstep = (size_t)(BK * 2);
    const size_t hA = (size_t)HALF * g.lda * 2, hB = (size_t)HALF * g.ldb * 2;
    const size_t tA = 2 * hA, tB = 2 * hB;
    const unsigned ldsw = (unsigned)wid * 1024u;
    const int aoff = lds_byte(wr * 64 + fr, fq * 8), boff = lds_byte(wc * 32 + fr, fq * 8);
#define PG8_SA(b, h) (((b) * 2 + (h)) * HTB)
#define PG8_SB(b, h) ((4 + (b) * 2 + (h)) * HTB)
#define PG8_STAGE(bufoff, gbase, voff) do { _Pragma("unroll") for (int _i = 0; _i < 2; ++_i) \
        __builtin_amdgcn_global_load_lds((const unsigned*)((const char*)(gbase) + (voff)[_i]), (LAS unsigned*)(lds + (bufoff) + ldsw + _i * 8192), 16, 0, 0); } while (0)
#define PG8_LDA(dst, b, h) do { _Pragma("unroll") for (int m = 0; m < 4; ++m) _Pragma("unroll") for (int k = 0; k < 2; ++k) dst[m][k] = *(const LAS bf16x8*)(lds + PG8_SA(b, h) + aoff + m * 2048 + k * 1024); } while (0)
#define PG8_LDB(dst, b, h) do { _Pragma("unroll") for (int n = 0; n < 2; ++n) _Pragma("unroll") for (int k = 0; k < 2; ++k) dst[n][k] = *(const LAS bf16x8*)(lds + PG8_SB(b, h) + boff + n * 2048 + k * 1024); } while (0)
#define PG8_MMA(ai, bj, At, Bt) do { __builtin_amdgcn_s_setprio(1); _Pragma("unroll") for (int m = 0; m < 4; ++m) _Pragma("unroll") for (int n = 0; n < 2; ++n) _Pragma("unroll") for (int k = 0; k < 2; ++k) \
        acc[ai][bj][m][n] = __builtin_amdgcn_mfma_f32_16x16x32_bf16(Bt[n][k], At[m][k], acc[ai][bj][m][n], 0, 0, 0); __builtin_amdgcn_s_setprio(0); } while (0)
#define PG8_WAIT_V(n) asm volatile("s_waitcnt vmcnt(" #n ")" ::: "memory")
#define PG8_WAIT_L(n) asm volatile("s_waitcnt lgkmcnt(" #n ")" ::: "memory")
#define PG8_BAR __builtin_amdgcn_s_barrier()
#define PG8_SCHED __builtin_amdgcn_sched_barrier(0)
    Unit cur, nxt; int ui = 0;
    if (!S.next(0, cur)) return;
    f32x4 acc[2][2][4][2];
#pragma unroll
    for (int a = 0; a < 2; ++a)
#pragma unroll
        for (int b = 0; b < 2; ++b)
#pragma unroll
            for (int m = 0; m < 4; ++m)
#pragma unroll
                for (int n = 0; n < 2; ++n) acc[a][b][m][n] = (f32x4){0.f, 0.f, 0.f, 0.f};
    bf16x8 At[4][2], B0[2][2], B1[2][2];
    const char* cA = (const char*)g.A + (size_t)cur.pm * tA; const char* cB = (const char*)g.Bt + (size_t)cur.pn * tB;
    PG8_STAGE(PG8_SB(0, 0), cB, voffB); PG8_STAGE(PG8_SB(0, 1), cB + hB, voffB); PG8_STAGE(PG8_SA(0, 0), cA, voffA); PG8_STAGE(PG8_SA(0, 1), cA + hA, voffA);
    if (wr == 1) PG8_BAR;
    PG8_WAIT_V(2); PG8_BAR;
    PG8_STAGE(PG8_SB(1, 0), cB + kstep, voffB); PG8_STAGE(PG8_SA(1, 0), cA + kstep, voffA); PG8_STAGE(PG8_SB(1, 1), cB + hB + kstep, voffB);
    PG8_WAIT_V(6); PG8_BAR;
    for (;;) {
        const bool has_next = S.next(ui + 1, nxt);
        const char* nA = has_next ? (const char*)g.A + (size_t)nxt.pm * tA : cA; const char* nB = has_next ? (const char*)g.Bt + (size_t)nxt.pn * tB : cB;
        for (int t = 0; t < nt; t += 2) {
            const bool last = (t == nt - 2);
            const char* a1 = cA + (size_t)(t + 1) * kstep;
            const char* a2 = last ? nA : cA + (size_t)(t + 2) * kstep; const char* b2 = last ? nB : cB + (size_t)(t + 2) * kstep;
            const char* a3 = a2 + kstep; const char* b3 = b2 + kstep;
            if constexpr (Epi::HAS_MID) { if (t == nt / 2) E.mid(acc, cur, wr, wc, fr, fq); }
            PG8_LDB(B0, 0, 0); PG8_LDB(B1, 0, 1); PG8_SCHED; PG8_LDA(At, 0, 0); PG8_STAGE(PG8_SA(1, 1), a1 + hA, voffA);
            PG8_WAIT_V(8); PG8_WAIT_L(0); PG8_BAR; PG8_MMA(0, 0, At, B0); PG8_MMA(0, 1, At, B1); PG8_BAR; PG8_SCHED;
            PG8_LDA(At, 0, 1); PG8_STAGE(PG8_SB(0, 0), b2, voffB); PG8_STAGE(PG8_SB(0, 1), b2 + hB, voffB); PG8_STAGE(PG8_SA(0, 0), a2, voffA);
            PG8_WAIT_V(8); PG8_WAIT_L(0); PG8_BAR; PG8_MMA(1, 0, At, B0); PG8_MMA(1, 1, At, B1); PG8_BAR; PG8_SCHED;
            PG8_LDB(B0, 1, 0); PG8_LDB(B1, 1, 1); PG8_SCHED; PG8_LDA(At, 1, 0); PG8_STAGE(PG8_SA(0, 1), a2 + hA, voffA);
            PG8_WAIT_V(8); PG8_WAIT_L(0); PG8_BAR; PG8_MMA(0, 0, At, B0); PG8_MMA(0, 1, At, B1); PG8_BAR; PG8_SCHED;
            PG8_LDA(At, 1, 1); PG8_STAGE(PG8_SB(1, 0), b3, voffB); PG8_STAGE(PG8_SB(1, 1), b3 + hB, voffB); PG8_STAGE(PG8_SA(1, 0), a3, voffA);
            PG8_WAIT_V(8); PG8_WAIT_L(0); PG8_BAR; PG8_MMA(1, 0, At, B0); PG8_MMA(1, 1, At, B1); PG8_BAR; PG8_SCHED;
        }
        if (wr == 0) PG8_BAR;
        if constexpr (!Epi::AFTER_DRAIN) E(acc, cur, wr, wc, fr, fq);
        if (!has_next) break;
#pragma unroll
        for (int a = 0; a < 2; ++a)
#pragma unroll
            for (int b = 0; b < 2; ++b)
#pragma unroll
                for (int m = 0; m < 4; ++m)
#pragma unroll
                    for (int n = 0; n < 2; ++n) acc[a][b][m][n] = (f32x4){0.f, 0.f, 0.f, 0.f};
        cur = nxt; cA = nA; cB = nB; ++ui;
        if (wr == 1) PG8_BAR;
    }
    PG8_WAIT_V(0);
    PG8_BAR;
    if constexpr (Epi::AFTER_DRAIN) E.fused(acc, cur, lds);
#undef PG8_SA
#undef PG8_SB
#undef PG8_STAGE
#undef PG8_LDA
#undef PG8_LDB
#undef PG8_MMA
#undef PG8_WAIT_V
#undef PG8_WAIT_L
#undef PG8_BAR
#undef PG8_SCHED
}
}

typedef f32x4 Acc[2][2][4][2];

struct Params {
    const float *x_p, *x_s, *c_p, *c_s, *st_C, *st_n, *st_m, *ck, *cv, *st_conv;
    const float *w_ada, *b_ada, *w_in, *b_in, *mnorm, *sinks, *w_bm, *w_ba, *w_out, *ln1g, *ln1b, *w_up, *b_up, *conv_w, *conv_b, *w_down, *b_down, *ln2g, *ln2b;
    float* out; unsigned char* ws;
};

typedef const __attribute__((address_space(4))) Params* PP;
__device__ __forceinline__ int seq_of_row(int row) { return row < MP ? (row >> 13) : 2 + ((row - MP) >> 2); }

struct EpiZ {
    static constexpr bool PERM = true, HAS_MID = false, AFTER_DRAIN = false;
    unsigned char* ws; const float* biasz;
    __device__ __forceinline__ void operator()(const Acc& acc, const pg8::Unit& u, int wr, int wc, int fr, int fq) const {
        { int tv_ = threadIdx.x; asm volatile("" : "+v"(tv_)); fr = tv_ & 15; fq = (tv_ >> 4) & 3; wc = (tv_ >> 6) & 3; wr = tv_ >> 8; }
        const int pn = u.pn; size_t slab; int ldc, cb; float sc = 1.f;
        if (pn < 4) { slab = WS_Z0; ldc = 1024; cb = pn * 256; if (pn < 2) sc = 0.08838834764831845f; }
        else if (pn < 12) { slab = WS_Z1; ldc = 2048; cb = (pn - 4) * 256; if (pn >= 8) sc = 0.125f; }
        else if (pn < 14) { slab = WS_Z2; ldc = 512; cb = (pn - 12) * 256; }
        else if (pn < 18) { slab = WS_Z3; ldc = 1024; cb = (pn - 14) * 256; }
        else { slab = WS_Z4; ldc = 2048; cb = (pn - 18) * 256; }
        bf16_t* base = (bf16_t*)(ws + slab);
        const int row0 = u.pm * 256 + wr * 64 + fr, col0 = cb + wc * 32 + 8 * fq, bcol0 = pn * 256 + wc * 32 + 8 * fq;
        f32x4 bv[2][2];
#pragma unroll
        for (int bj = 0; bj < 2; ++bj)
#pragma unroll
            for (int n = 0; n < 2; ++n) bv[bj][n] = *(const f32x4*)(biasz + bcol0 + bj * 128 + 4 * n);
#pragma unroll
        for (int ai = 0; ai < 2; ++ai)
#pragma unroll
            for (int m = 0; m < 4; ++m) { bf16_t* rowp = base + (size_t)(row0 + ai * 128 + m * 16) * ldc + col0;
#pragma unroll
                for (int bj = 0; bj < 2; ++bj) { f32x4 v0 = (acc[ai][bj][m][0] + bv[bj][0]) * sc, v1 = (acc[ai][bj][m][1] + bv[bj][1]) * sc;
                    if (pn >= 14) { v0 = (f32x4){sigmoidf_(v0[0]), sigmoidf_(v0[1]), sigmoidf_(v0[2]), sigmoidf_(v0[3])}; v1 = (f32x4){sigmoidf_(v1[0]), sigmoidf_(v1[1]), sigmoidf_(v1[2]), sigmoidf_(v1[3])}; }
                    u32x4 w; w.x = pk2(v0[0], v0[1]); w.y = pk2(v0[2], v0[3]); w.z = pk2(v1[0], v1[1]); w.w = pk2(v1[2], v1[3]);
                    *(u32x4*)(rowp + bj * 128) = w; } }
    }
};

struct EpiBranch {
    static constexpr bool PERM = true, HAS_MID = true, AFTER_DRAIN = false;
    const bf16_t* Z4; bf16_t* O;
    __device__ __forceinline__ void mid(Acc& acc, const pg8::Unit& u, int wr, int wc, int fr, int fq) const {
        { int tv_ = threadIdx.x; asm volatile("" : "+v"(tv_)); fr = tv_ & 15; fq = (tv_ >> 4) & 3; wc = (tv_ >> 6) & 3; wr = tv_ >> 8; }
        const int row0 = u.pm * 256 + wr * 64 + fr, col0 = u.pn * 256 + wc * 32 + 8 * fq;
#pragma unroll
        for (int ai = 0; ai < 2; ++ai)
#pragma unroll
            for (int m = 0; m < 4; ++m) { const bf16_t* rp = Z4 + (size_t)(row0 + ai * 128 + m * 16) * 2048 + col0;
#pragma unroll
                for (int bj = 0; bj < 2; ++bj) { const u32x4 gm = *(const u32x4*)(rp + bj * 128), ga = *(const u32x4*)(rp + 1024 + bj * 128);
#pragma unroll
                    for (int q = 0; q < 4; ++q) { const float m0 = lo16(gm[q]), m1 = hi16(gm[q]), a0 = lo16(ga[q]), a1 = hi16(ga[q]);
                        const float r0 = m0 * __builtin_amdgcn_rcpf(a0), r1 = m1 * __builtin_amdgcn_rcpf(a1);
                        acc[ai][bj][m][q >> 1][(q & 1) * 2] *= r0; acc[ai][bj][m][q >> 1][(q & 1) * 2 + 1] *= r1; } } }
    }
    __device__ __forceinline__ void operator()(const Acc& acc, const pg8::Unit& u, int wr, int wc, int fr, int fq) const {
        { int tv_ = threadIdx.x; asm volatile("" : "+v"(tv_)); fr = tv_ & 15; fq = (tv_ >> 4) & 3; wc = (tv_ >> 6) & 3; wr = tv_ >> 8; }
        const int row0 = u.pm * 256 + wr * 64 + fr, col0 = u.pn * 256 + wc * 32 + 8 * fq;
#pragma unroll
        for (int ai = 0; ai < 2; ++ai)
#pragma unroll
            for (int m = 0; m < 4; ++m) { const size_t r = (size_t)(row0 + ai * 128 + m * 16);
#pragma unroll
                for (int bj = 0; bj < 2; ++bj) { const u32x4 ga = *(const u32x4*)(Z4 + r * 2048 + 1024 + col0 + bj * 128);
                    float v[8];
#pragma unroll
                    for (int q = 0; q < 4; ++q) { v[2 * q] = acc[ai][bj][m][q >> 1][(q & 1) * 2] * lo16(ga[q]); v[2 * q + 1] = acc[ai][bj][m][q >> 1][(q & 1) * 2 + 1] * hi16(ga[q]); }
                    u32x4 w; w.x = pk2(v[0], v[1]); w.y = pk2(v[2], v[3]); w.z = pk2(v[4], v[5]); w.w = pk2(v[6], v[7]);
                    *(u32x4*)(O + r * 1024 + col0 + bj * 128) = w; } }
    }
};

struct EpiRes {
    static constexpr bool PERM = false, HAS_MID = false, AFTER_DRAIN = false;
    const float *xp, *xs; const float* mod; int goff; bf16_t* obf;
    __device__ __forceinline__ void operator()(const Acc& acc, const pg8::Unit& u, int wr, int wc, int fr, int fq) const {
        { int tv_ = threadIdx.x; asm volatile("" : "+v"(tv_)); fr = tv_ & 15; fq = (tv_ >> 4) & 3; wc = (tv_ >> 6) & 3; wr = tv_ >> 8; }
        const int col0 = u.pn * 256 + wc * 32 + 4 * fq;
        const float* g = mod + (size_t)seq_of_row(u.pm * 256) * 6144 + goff;
        f32x4 gvv[2][2];
#pragma unroll
        for (int bj = 0; bj < 2; ++bj)
#pragma unroll
            for (int n = 0; n < 2; ++n) gvv[bj][n] = *(const f32x4*)(g + col0 + bj * 128 + n * 16);
#pragma unroll
        for (int ai = 0; ai < 2; ++ai)
#pragma unroll
            for (int m = 0; m < 4; ++m) { const int row = u.pm * 256 + ai * 128 + wr * 64 + m * 16 + fr;
                const float* bp = row < MP ? xp + (size_t)row * 1024 : xs + (size_t)(row - MP) * 1024;
#pragma unroll
                for (int bj = 0; bj < 2; ++bj)
#pragma unroll
                    for (int n = 0; n < 2; ++n) { const int c = col0 + bj * 128 + n * 16; const f32x4 gv = gvv[bj][n], xv = *(const f32x4*)(bp + c);
                        const f32x4 o = xv * ALPHA + gv * acc[ai][bj][m][n]; u32x2 w; w.x = pk2(o[0], o[1]); w.y = pk2(o[2], o[3]);
                        *(u32x2*)(obf + (size_t)row * 1024 + c) = w; } }
    }
};

struct EpiUp {
    static constexpr bool PERM = true, HAS_MID = false, AFTER_DRAIN = false;
    const float *b_up, *conv_w, *conv_b; bf16_t *scr, *UB, *US, *ACT; const float* st_conv; float* s_conv;
    __device__ __forceinline__ void operator()(const Acc& acc, const pg8::Unit& u, int wr, int wc, int fr, int fq) const {
        { int tv_ = threadIdx.x; asm volatile("" : "+v"(tv_)); fr = tv_ & 15; fq = (tv_ >> 4) & 3; wc = (tv_ >> 6) & 3; wr = tv_ >> 8; }
        const int pn = u.pn, pm = u.pm;
        const int cl0 = wc * 32 + 8 * fq;
        f32x4 bv[2][2];
#pragma unroll
        for (int bj = 0; bj < 2; ++bj)
#pragma unroll
            for (int n = 0; n < 2; ++n) bv[bj][n] = *(const f32x4*)(b_up + bj * DFF + pn * 128 + cl0 + 4 * n);
#pragma unroll
        for (int ai = 0; ai < 2; ++ai)
#pragma unroll
            for (int m = 0; m < 4; ++m) { const int rt = ai * 128 + wr * 64 + m * 16 + fr;
#pragma unroll
                for (int bj = 0; bj < 2; ++bj) { const f32x4 v0 = acc[ai][bj][m][0] + bv[bj][0], v1 = acc[ai][bj][m][1] + bv[bj][1];
                    u32x4 w; w.x = pk2(v0[0], v0[1]); w.y = pk2(v0[2], v0[3]); w.z = pk2(v1[0], v1[1]); w.w = pk2(v1[2], v1[3]);
                    *(u32x4*)(scr + rt * 256 + bj * 128 + cl0) = w; }
                __builtin_amdgcn_sched_barrier(0); }
        asm volatile("s_waitcnt vmcnt(0)" ::: "memory"); __builtin_amdgcn_s_barrier(); asm volatile("" ::: "memory");
        const int tid = threadIdx.x;
#define SCR_LD(p) __hip_atomic_load((const unsigned*)(p), __ATOMIC_RELAXED, __HIP_MEMORY_SCOPE_AGENT)
        if (pm >= 64) {
            const int f0 = (tid & 63) * 2, ca = pn * 128 + f0;
            const f32x2 cba = *(const f32x2*)(conv_b + ca), cbg = *(const f32x2*)(conv_b + DFF + ca);
            const f32x2 wa0 = *(const f32x2*)(conv_w + ca), wa1 = *(const f32x2*)(conv_w + F2 + ca), wa2 = *(const f32x2*)(conv_w + 2 * F2 + ca);
            const f32x2 wg0 = *(const f32x2*)(conv_w + DFF + ca), wg1 = *(const f32x2*)(conv_w + F2 + DFF + ca), wg2 = *(const f32x2*)(conv_w + 2 * F2 + DFF + ca);
#pragma unroll 1
            for (int hb = 0; hb < 2; ++hb) { const int r0 = (tid >> 6) * 32 + 16 * hb;
                unsigned ua[16], ug[16];
#pragma unroll
                for (int i = 0; i < 16; ++i) { ua[i] = SCR_LD(scr + (r0 + i) * 256 + f0); ug[i] = SCR_LD(scr + (r0 + i) * 256 + 128 + f0); }
#pragma unroll
                for (int sq4 = 0; sq4 < 4; ++sq4) { const int srow0 = (pm - 64) * 256 + r0 + 4 * sq4, bq = srow0 >> 2;
                    const f32x2 c0a = *(const f32x2*)(st_conv + ((size_t)bq * 2 + 0) * F2 + ca), c1a = *(const f32x2*)(st_conv + ((size_t)bq * 2 + 1) * F2 + ca);
                    const f32x2 c0g = *(const f32x2*)(st_conv + ((size_t)bq * 2 + 0) * F2 + DFF + ca), c1g = *(const f32x2*)(st_conv + ((size_t)bq * 2 + 1) * F2 + DFF + ca);
#pragma unroll
                    for (int t = 0; t < 4; ++t) { const int it = 4 * sq4 + t;
                        const f32x2 xa2 = (f32x2){lo16(ua[it]), hi16(ua[it])}, xg2 = (f32x2){lo16(ug[it]), hi16(ug[it])};
                        const f32x2 xa1 = t >= 1 ? (f32x2){lo16(ua[it - (t >= 1 ? 1 : 0)]), hi16(ua[it - (t >= 1 ? 1 : 0)])} : c1a, xg1 = t >= 1 ? (f32x2){lo16(ug[it - (t >= 1 ? 1 : 0)]), hi16(ug[it - (t >= 1 ? 1 : 0)])} : c1g;
                        const f32x2 xa0 = t >= 2 ? (f32x2){lo16(ua[it - (t >= 2 ? 2 : 0)]), hi16(ua[it - (t >= 2 ? 2 : 0)])} : (t == 0 ? c0a : c1a), xg0 = t >= 2 ? (f32x2){lo16(ug[it - (t >= 2 ? 2 : 0)]), hi16(ug[it - (t >= 2 ? 2 : 0)])} : (t == 0 ? c0g : c1g);
                        const float av0 = cba[0] + wa0[0] * xa0[0] + wa1[0] * xa1[0] + wa2[0] * xa2[0], av1 = cba[1] + wa0[1] * xa0[1] + wa1[1] * xa1[1] + wa2[1] * xa2[1];
                        const float gv0 = cbg[0] + wg0[0] * xg0[0] + wg1[0] * xg1[0] + wg2[0] * xg2[0], gv1 = cbg[1] + wg0[1] * xg0[1] + wg1[1] * xg1[1] + wg2[1] * xg2[1];
                        *(unsigned*)(ACT + (size_t)(MP + srow0 + t) * DFF + ca) = pk2(gelu_tanh(av0) * gv0, gelu_tanh(av1) * gv1);
                        if (t >= 2) { *(f32x2*)(s_conv + ((size_t)bq * 2 + (t - 2)) * F2 + ca) = xa2; *(f32x2*)(s_conv + ((size_t)bq * 2 + (t - 2)) * F2 + DFF + ca) = xg2; } } } }
        } else
        {
            const int f0 = (tid & 63) * 2, ca = pn * 128 + f0;
            const f32x2 cba = *(const f32x2*)(conv_b + ca), cbg = *(const f32x2*)(conv_b + DFF + ca);
            const f32x2 wa0 = *(const f32x2*)(conv_w + ca), wa1 = *(const f32x2*)(conv_w + F2 + ca), wa2 = *(const f32x2*)(conv_w + 2 * F2 + ca);
            const f32x2 wg0 = *(const f32x2*)(conv_w + DFF + ca), wg1 = *(const f32x2*)(conv_w + F2 + DFF + ca), wg2 = *(const f32x2*)(conv_w + 2 * F2 + DFF + ca);
#pragma unroll 1
            for (int hb = 0; hb < 2; ++hb) { const int r0 = (tid >> 6) * 32 + 16 * hb;
            unsigned ua[18], ug[18];
#pragma unroll
            for (int i = 0; i < 18; ++i) { int r = r0 - 2 + i; r = r < 0 ? 0 : r; ua[i] = SCR_LD(scr + r * 256 + f0); ug[i] = SCR_LD(scr + r * 256 + 128 + f0); }
#pragma unroll
            for (int it = 0; it < 16; ++it) { const int rt = r0 + it; const unsigned a0 = ua[it], a1 = ua[it + 1], a2 = ua[it + 2], g0 = ug[it], g1 = ug[it + 1], g2 = ug[it + 2];
                if (rt < 2) { *(unsigned*)(UB + ((size_t)pm * 4 + 2 + rt) * F2 + ca) = a2; *(unsigned*)(UB + ((size_t)pm * 4 + 2 + rt) * F2 + DFF + ca) = g2; continue; }
                if (rt >= 254) { *(unsigned*)(UB + ((size_t)(pm + 1) * 4 + (rt - 254)) * F2 + ca) = a2; *(unsigned*)(UB + ((size_t)(pm + 1) * 4 + (rt - 254)) * F2 + DFF + ca) = g2; }
                const float av0 = cba[0] + wa0[0] * lo16(a0) + wa1[0] * lo16(a1) + wa2[0] * lo16(a2), av1 = cba[1] + wa0[1] * hi16(a0) + wa1[1] * hi16(a1) + wa2[1] * hi16(a2);
                const float gv0 = cbg[0] + wg0[0] * lo16(g0) + wg1[0] * lo16(g1) + wg2[0] * lo16(g2), gv1 = cbg[1] + wg0[1] * hi16(g0) + wg1[1] * hi16(g1) + wg2[1] * hi16(g2);
                *(unsigned*)(ACT + (size_t)(pm * 256 + rt) * DFF + ca) = pk2(gelu_tanh(av0) * gv0, gelu_tanh(av1) * gv1); }
            }
        }
#undef SCR_LD
        asm volatile("s_waitcnt vmcnt(0)" ::: "memory"); __builtin_amdgcn_s_barrier();
    }
};


struct EpiDownLn {
    static constexpr bool PERM = false, HAS_MID = false, AFTER_DRAIN = true;
    const float* mod; const float *bias, *gam, *bet; float* out; const bf16_t* x1; unsigned long long* xbuf; unsigned* cnt;
    __device__ __forceinline__ void fused(Acc& acc, const pg8::Unit& u, LAS unsigned char* lds) const {
        int tv_ = threadIdx.x; asm volatile("" : "+v"(tv_));
        const int lane = tv_ & 63, wid = __builtin_amdgcn_readfirstlane(tv_ >> 6), fr = lane & 15, fq = lane >> 4, wc = wid & 3, wr = wid >> 2;
        LAS f32x2* Pp = (LAS f32x2*)lds;
        LAS f32x2* S = (LAS f32x2*)(lds + 8192);
        const int col0 = u.pn * 256 + wc * 32 + 4 * fq;
        const float* g = mod + (size_t)(u.pm >> 5) * 6144 + 5120;
#pragma unroll
        for (int bj = 0; bj < 2; ++bj)
#pragma unroll
            for (int n = 0; n < 2; ++n) { const int c = col0 + bj * 128 + n * 16; const f32x4 gv = *(const f32x4*)(g + c), bv = *(const f32x4*)(bias + c);
#pragma unroll
                for (int ai = 0; ai < 2; ++ai)
#pragma unroll
                    for (int m = 0; m < 4; ++m) acc[ai][bj][m][n] = gv * (acc[ai][bj][m][n] + bv); }
#pragma unroll
        for (int ai = 0; ai < 2; ++ai)
#pragma unroll
            for (int m = 0; m < 4; ++m) { const bf16_t* xr = x1 + (size_t)(u.pm * 256 + ai * 128 + wr * 64 + m * 16 + fr) * 1024 + col0;
#pragma unroll
                for (int bj = 0; bj < 2; ++bj)
#pragma unroll
                    for (int n = 0; n < 2; ++n) { const u32x2 xw = *(const u32x2*)(xr + bj * 128 + n * 16); acc[ai][bj][m][n] = acc[ai][bj][m][n] + (f32x4){lo16(xw.x), hi16(xw.x), lo16(xw.y), hi16(xw.y)} * ALPHA; }
                asm volatile("" : "+v"(acc[ai][0][m][0]), "+v"(acc[ai][0][m][1]), "+v"(acc[ai][1][m][0]), "+v"(acc[ai][1][m][1]));
                if (m & 1) asm volatile("" ::: "memory"); }
#pragma unroll
        for (int ai = 0; ai < 2; ++ai)
#pragma unroll
            for (int m = 0; m < 4; ++m) { float s = 0.f;
#pragma unroll
                for (int bj = 0; bj < 2; ++bj)
#pragma unroll
                    for (int n = 0; n < 2; ++n) { const f32x4 x = acc[ai][bj][m][n]; s += (x[0] + x[1]) + (x[2] + x[3]); }
                s += __shfl_xor(s, 16); s += __shfl_xor(s, 32);
                const float mw = s * (1.0f / 64.0f); float q = 0.f;
#pragma unroll
                for (int bj = 0; bj < 2; ++bj)
#pragma unroll
                    for (int n = 0; n < 2; ++n) { const f32x4 d = acc[ai][bj][m][n] - mw; q += (d[0] * d[0] + d[1] * d[1]) + (d[2] * d[2] + d[3] * d[3]); }
                q += __shfl_xor(q, 16); q += __shfl_xor(q, 32);
                if (fq == 0) Pp[(ai * 128 + wr * 64 + m * 16 + fr) * 4 + wc] = (f32x2){mw, q}; }
        asm volatile("s_waitcnt lgkmcnt(0)" ::: "memory"); __builtin_amdgcn_s_barrier(); asm volatile("" ::: "memory");
        const int row = wid * 32 + (lane & 31);
        if (lane < 32) { const f32x2 a = Pp[row * 4 + 0], b = Pp[row * 4 + 1], cc = Pp[row * 4 + 2], d = Pp[row * 4 + 3];
            const float mt = (a.x + b.x + cc.x + d.x) * 0.25f; const float da = a.x - mt, db = b.x - mt, dc = cc.x - mt, dd = d.x - mt;
            const float m2 = (a.y + b.y) + (cc.y + d.y) + 64.0f * ((da * da + db * db) + (dc * dc + dd * dd));
            __hip_atomic_store(xbuf + ((size_t)(u.pm * 256 + row) * 4 + u.pn), ((unsigned long long)__float_as_uint(m2) << 32) | __float_as_uint(mt), __ATOMIC_RELAXED, __HIP_MEMORY_SCOPE_AGENT); }
        asm volatile("s_waitcnt vmcnt(0)" ::: "memory");
        if (lane == 0) __hip_atomic_fetch_add(cnt + 64 * u.pm, 1u, __ATOMIC_RELAXED, __HIP_MEMORY_SCOPE_AGENT);
        if (wid == 0) { unsigned sp = 0;
            while ((unsigned)__builtin_amdgcn_readfirstlane(__hip_atomic_load(cnt + 64 * u.pm, __ATOMIC_RELAXED, __HIP_MEMORY_SCOPE_AGENT)) < 32u) { __builtin_amdgcn_s_sleep(2); if (++sp > (1u << 24)) break; }
            __builtin_amdgcn_fence(__ATOMIC_ACQUIRE, "agent"); }
        asm volatile("s_waitcnt vmcnt(0) lgkmcnt(0)" ::: "memory"); __builtin_amdgcn_s_barrier(); asm volatile("" ::: "memory");
        if (lane < 32) { const unsigned long long* slot = xbuf + (size_t)(u.pm * 256 + row) * 4; float mt[4], m2[4]; float ms = 0.f;
#pragma unroll
            for (int t = 0; t < 4; ++t) { const unsigned long long w = __hip_atomic_load(slot + t, __ATOMIC_RELAXED, __HIP_MEMORY_SCOPE_AGENT); mt[t] = __uint_as_float((unsigned)w); m2[t] = __uint_as_float((unsigned)(w >> 32)); ms += mt[t]; }
            const float mean = ms * 0.25f; float q = 0.f;
#pragma unroll
            for (int t = 0; t < 4; ++t) { const float dm = mt[t] - mean; q += m2[t] + 256.0f * dm * dm; }
            S[row] = (f32x2){mean, 1.0f / sqrtf(q * (1.0f / 1024.0f) + LN_EPS)}; }
        asm volatile("s_waitcnt lgkmcnt(0)" ::: "memory"); __builtin_amdgcn_s_barrier(); asm volatile("" ::: "memory");
#pragma unroll
        for (int bj = 0; bj < 2; ++bj)
#pragma unroll
            for (int n = 0; n < 2; ++n) { const int c = col0 + bj * 128 + n * 16; const f32x4 gm = *(const f32x4*)(gam + c), bt = *(const f32x4*)(bet + c);
#pragma unroll
                for (int ai = 0; ai < 2; ++ai)
#pragma unroll
                    for (int m = 0; m < 4; ++m) { const int r = ai * 128 + wr * 64 + m * 16 + fr; const f32x2 sr = S[r];
                        *(f32x4*)(out + (size_t)(u.pm * 256 + r) * 1024 + c) = (acc[ai][bj][m][n] - sr.x) * sr.y * gm + bt; } }
    }
    __device__ __forceinline__ void operator()(const Acc&, const pg8::Unit&, int, int, int, int) const {}
};

struct Ctx { int tid, lane, wave, vw, nvw; };

__device__ __forceinline__ void transpose_item(const float* W, int ldw, int k0, int csrc, bf16_t* dst, int ldd, int drow, int dcol, float* scr, int lane) {
    float tv_[32];
#pragma unroll
    for (int i = 0; i < 32; ++i) tv_[i] = W[(size_t)(k0 + 2 * i + (lane >> 5)) * ldw + csrc + (lane & 31)];
#pragma unroll
    for (int i = 0; i < 32; ++i) scr[(2 * i + (lane >> 5)) * 33 + (lane & 31)] = tv_[i];
    __builtin_amdgcn_fence(__ATOMIC_RELEASE, "wavefront"); asm volatile("s_waitcnt lgkmcnt(0)" ::: "memory");
    const int c = lane & 7;
#pragma unroll
    for (int j = 0; j < 4; ++j) { const int n = (lane >> 3) + 8 * j; const float* s = scr + (8 * c) * 33 + n;
        u32x4 o; o.x = pk2(s[0 * 33], s[1 * 33]); o.y = pk2(s[2 * 33], s[3 * 33]); o.z = pk2(s[4 * 33], s[5 * 33]); o.w = pk2(s[6 * 33], s[7 * 33]);
        *(u32x4*)(dst + (size_t)(drow + n) * ldd + dcol + k0 + 8 * c) = o; }
    asm volatile("s_waitcnt lgkmcnt(0)" ::: "memory");
}
__device__ __forceinline__ int srcmap(int c) { return c < 2048 ? c : (c < 3584 ? c + 1032 : (c < 4608 ? c - 1528 : c + 8)); }

__device__ __forceinline__ void ada_task(PP P, int task, int lane) {
    const int n0 = (task / 3) * 16, rt0 = (task % 3) * 3, fr = lane & 15, kg = lane >> 4;
    f32x4 acc[3];
#pragma unroll
    for (int r = 0; r < 3; ++r) acc[r] = (f32x4){0.f, 0.f, 0.f, 0.f};
    const float* crow[3];
#pragma unroll
    for (int r = 0; r < 3; ++r) { int s = 16 * (rt0 + r) + fr; if (s > NSEQ - 1) s = NSEQ - 1; crow[r] = s < 2 ? P->c_p + (size_t)s * D : P->c_s + (size_t)(s - 2) * D; }
#pragma unroll 4
    for (int ks = 0; ks < 32; ++ks) { const int k0 = ks * 32 + 8 * kg;
        float wv[8];
#pragma unroll
        for (int j = 0; j < 8; ++j) wv[j] = P->w_ada[(size_t)(k0 + j) * 6144 + n0 + fr];
        bf16x8 b;
#pragma unroll
        for (int j = 0; j < 8; ++j) b[j] = (short)f2bf(wv[j]);
#pragma unroll
        for (int r = 0; r < 3; ++r) { const f32x4 c0 = *(const f32x4*)(crow[r] + k0), c1 = *(const f32x4*)(crow[r] + k0 + 4);
            bf16x8 a;
#pragma unroll
            for (int j = 0; j < 4; ++j) { a[j] = (short)f2bf(c0[j] * sigmoidf_(c0[j])); a[4 + j] = (short)f2bf(c1[j] * sigmoidf_(c1[j])); }
            acc[r] = __builtin_amdgcn_mfma_f32_16x16x32_bf16(a, b, acc[r], 0, 0, 0); } }
    float* mod = (float*)(P->ws + WS_MOD); const float bb = P->b_ada[n0 + fr];
#pragma unroll
    for (int r = 0; r < 3; ++r)
#pragma unroll
        for (int j = 0; j < 4; ++j) { const int s = 16 * (rt0 + r) + 4 * kg + j; if (s < NSEQ) mod[(size_t)s * 6144 + n0 + fr] = acc[r][j] + bb; }
}

constexpr int APITCH = 1032;
__device__ __forceinline__ void ada_block_task(PP P, unsigned char* lds, const Ctx& c, int task) {
    const int rg = task % 3, cg = task / 3, fr = c.lane & 15, kg = c.lane >> 4;
    bf16_t* As = (bf16_t*)lds;
#pragma unroll 12
    for (int i = 0; i < 24; ++i) { const int id = c.tid + 512 * i, r = id >> 8, k4 = id & 255; int s = 48 * rg + r; s = s > NSEQ - 1 ? NSEQ - 1 : s;
        const float* src = s < 2 ? P->c_p + (size_t)s * D : P->c_s + (size_t)(s - 2) * D; const f32x4 v = *(const f32x4*)(src + 4 * k4);
        u32x2 w; w.x = pk2(v[0] * sigmoidf_(v[0]), v[1] * sigmoidf_(v[1])); w.y = pk2(v[2] * sigmoidf_(v[2]), v[3] * sigmoidf_(v[3]));
        *(u32x2*)(As + r * APITCH + 4 * k4) = w; }
    __syncthreads();
    const int n0 = 128 * cg + 16 * c.wave;
    f32x4 acc[3];
#pragma unroll
    for (int r = 0; r < 3; ++r) acc[r] = (f32x4){0.f, 0.f, 0.f, 0.f};
#pragma unroll 8
    for (int ks = 0; ks < 32; ++ks) { const int k0 = ks * 32 + 8 * kg;
        float wv[8];
#pragma unroll
        for (int j = 0; j < 8; ++j) wv[j] = P->w_ada[(size_t)(k0 + j) * 6144 + n0 + fr];
        u32x4 bw; bw.x = pk2(wv[0], wv[1]); bw.y = pk2(wv[2], wv[3]); bw.z = pk2(wv[4], wv[5]); bw.w = pk2(wv[6], wv[7]);
        const bf16x8 b = __builtin_bit_cast(bf16x8, bw);
#pragma unroll
        for (int r = 0; r < 3; ++r) { const bf16x8 a = *(const bf16x8*)(As + (16 * r + fr) * APITCH + k0); acc[r] = __builtin_amdgcn_mfma_f32_16x16x32_bf16(a, b, acc[r], 0, 0, 0); } }
    float* mod = (float*)(P->ws + WS_MOD); const float bb = P->b_ada[n0 + fr];
#pragma unroll
    for (int r = 0; r < 3; ++r)
#pragma unroll
        for (int j = 0; j < 4; ++j) { const int s = 48 * rg + 16 * r + 4 * kg + j; if (s < NSEQ) mod[(size_t)s * 6144 + n0 + fr] = acc[r][j] + bb; }
    __syncthreads();
}

__device__ __forceinline__ void phase0(PP P, unsigned char* lds, const Ctx& c) {
    float* scr = (float*)(lds + c.wave * 16384);
    { float* wg = (float*)(P->ws + WS_MISC + MISC_WG); float* bz = (float*)(P->ws + WS_MISC + MISC_BIASZ);
      for (int i = blockIdx.x * 512 + c.tid; i < 8192; i += gridDim.x * 512) { const int g = i >> 10, k = i & 1023; wg[i] = P->w_in[(size_t)k * DIN + 2048 + g]; }
      for (int i = blockIdx.x * 512 + c.tid; i < N1; i += gridDim.x * 512) bz[i] = P->b_in[srcmap(i)]; }
    constexpr int T_ADA = 144, I_IN = 16 * 208;
    const int G = gridDim.x, bid = blockIdx.x;
    if (G > T_ADA) {
        if (bid < T_ADA) { ada_block_task(P, lds, c, bid); return; }
        const int tv = (bid - T_ADA) * 8 + c.wave, tn = (G - T_ADA) * 8;
        for (int r = tv; r < I_IN; r += tn) { const int kb = r / 208, nb = r % 208; transpose_item(P->w_in, DIN, 64 * kb, srcmap(32 * nb), (bf16_t*)(P->ws + WS_W1T), 1024, 32 * nb, 0, scr, c.lane); }
    } else {
        for (int t = bid; t < T_ADA; t += G) ada_block_task(P, lds, c, t);
        for (int r = bid * 8 + c.wave; r < I_IN; r += G * 8) { const int kb = r / 208, nb = r % 208; transpose_item(P->w_in, DIN, 64 * kb, srcmap(32 * nb), (bf16_t*)(P->ws + WS_W1T), 1024, 32 * nb, 0, scr, c.lane); }
    }
}

__device__ __forceinline__ void late_copies_a(PP P, unsigned char* lds, const Ctx& c, int rank, int nrk) {
    float* scr = (float*)(lds + c.wave * 16384); constexpr int I_B = 512, I_UP = 16 * 176;
    for (int r = rank; r < I_B; r += nrk) { const int kb = r / 32, nb = r % 32; transpose_item(P->w_bm, 1024, 64 * kb, 32 * nb, (bf16_t*)(P->ws + WS_WBR), 2048, 32 * nb, 0, scr, c.lane); }
    for (int r = rank; r < I_B; r += nrk) { const int kb = r / 32, nb = r % 32; transpose_item(P->w_ba, 1024, 64 * kb, 32 * nb, (bf16_t*)(P->ws + WS_WBR), 2048, 32 * nb, 1024, scr, c.lane); }
    for (int r = rank; r < I_B; r += nrk) { const int kb = r / 32, nb = r % 32; transpose_item(P->w_out, 1024, 64 * kb, 32 * nb, (bf16_t*)(P->ws + WS_WOT), 1024, 32 * nb, 0, scr, c.lane); }
    for (int r = rank; r < I_UP; r += nrk) { const int kb = r / 176, nb = r % 176; const int cs = 32 * nb; const int j = cs < DFF ? cs : cs - DFF; const int drow = 256 * (j >> 7) + (cs < DFF ? 0 : 128) + (j & 127);
        transpose_item(P->w_up, F2, 64 * kb, cs, (bf16_t*)(P->ws + WS_WUT), 1024, drow, 0, scr, c.lane); }
}
__device__ __forceinline__ void late_copies_b(PP P, unsigned char* lds, const Ctx& c, int rank, int nrk) {
    float* scr = (float*)(lds + c.wave * 16384); constexpr int I_DN = 44 * 32;
    for (int r = rank; r < I_DN; r += nrk) { const int kb = r / 32, nb = r % 32; transpose_item(P->w_down, 1024, 64 * kb, 32 * nb, (bf16_t*)(P->ws + WS_WDT), DFF, 32 * nb, 0, scr, c.lane); }
}

__device__ __forceinline__ void ln_stats(const f32x4 (&v)[4], float& mean, float& rstd) {
    float s = 0.f, q = 0.f;
#pragma unroll
    for (int j = 0; j < 4; ++j) { s += (v[j][0] + v[j][1]) + (v[j][2] + v[j][3]); q += (v[j][0] * v[j][0] + v[j][1] * v[j][1]) + (v[j][2] * v[j][2] + v[j][3] * v[j][3]); }
#pragma unroll
    for (int o = 1; o < 64; o <<= 1) { s += __shfl_xor(s, o); q += __shfl_xor(q, o); }
    mean = s * (1.f / D);
    rstd = rsqrtf(fmaxf(q * (1.f / D) - mean * mean, 0.f) + LN_EPS);
}
__device__ __forceinline__ void phase1(PP P, const Ctx& c, bf16_t* H) {
    const float* mod = (const float*)(P->ws + WS_MOD); const float* wg = (const float*)(P->ws + WS_MISC + MISC_WG); float* gates = (float*)(P->ws + WS_GATES);
    f32x4 wgr[8][4];
#pragma unroll
    for (int g = 0; g < 8; ++g)
#pragma unroll
        for (int j = 0; j < 4; ++j) wgr[g][j] = *(const f32x4*)(wg + g * 1024 + 4 * c.lane + 256 * j);
    const int gsel = ((c.lane >> 5) & 1) * 4 + ((c.lane >> 4) & 1) * 2 + ((c.lane >> 3) & 1); const float gbias = P->b_in[2048 + gsel];
    f32x4 nv[4];
    if (c.vw < MT) { const int row = c.vw; const float* xr = row < MP ? P->x_p + (size_t)row * D : P->x_s + (size_t)(row - MP) * D;
#pragma unroll
        for (int j = 0; j < 4; ++j) nv[j] = *(const f32x4*)(xr + 4 * c.lane + 256 * j); }
    int cseq = -1; f32x4 shr[4], scr1[4];
    for (int row = c.vw; row < MT; row += c.nvw) {
        { const int sq = seq_of_row(row); if (sq != cseq) { cseq = sq; const float* mr = mod + (size_t)sq * 6144;
#pragma unroll
            for (int j = 0; j < 4; ++j) { shr[j] = *(const f32x4*)(mr + 4 * c.lane + 256 * j); scr1[j] = *(const f32x4*)(mr + 1024 + 4 * c.lane + 256 * j) + 1.f; } } }
        f32x4 v[4];
#pragma unroll
        for (int j = 0; j < 4; ++j) v[j] = nv[j];
        { const int nr = row + c.nvw; if (nr < MT) { const float* xr = nr < MP ? P->x_p + (size_t)nr * D : P->x_s + (size_t)(nr - MP) * D;
#pragma unroll
            for (int j = 0; j < 4; ++j) nv[j] = *(const f32x4*)(xr + 4 * c.lane + 256 * j); } }
        float mean, rstd; ln_stats(v, mean, rstd);
#pragma unroll
        for (int j = 0; j < 4; ++j) { v[j] = (v[j] - mean) * rstd * scr1[j] + shr[j];
            u32x2 w; w.x = pk2(v[j][0], v[j][1]); w.y = pk2(v[j][2], v[j][3]); *(u32x2*)(H + (size_t)row * D + 4 * c.lane + 256 * j) = w; }
        float gs[8];
#pragma unroll
        for (int g = 0; g < 8; ++g) { float s = 0.f;
#pragma unroll
            for (int j = 0; j < 4; ++j) { const f32x4 w = wgr[g][j]; s += (v[j][0] * w[0] + v[j][1] * w[1]) + (v[j][2] * w[2] + v[j][3] * w[3]); }
            gs[g] = s; }
        { const bool u5 = (c.lane & 32) != 0, u4 = (c.lane & 16) != 0, u3 = (c.lane & 8) != 0; float a4[4], a2[2], a1;
#pragma unroll
          for (int k = 0; k < 4; ++k) { const float send = u5 ? gs[k] : gs[k + 4], keep = u5 ? gs[k + 4] : gs[k]; a4[k] = keep + __shfl_xor(send, 32); }
#pragma unroll
          for (int k = 0; k < 2; ++k) { const float send = u4 ? a4[k] : a4[k + 2], keep = u4 ? a4[k + 2] : a4[k]; a2[k] = keep + __shfl_xor(send, 16); }
          { const float send = u3 ? a2[0] : a2[1], keep = u3 ? a2[1] : a2[0]; a1 = keep + __shfl_xor(send, 8); }
          a1 += __shfl_xor(a1, 4); a1 += __shfl_xor(a1, 2); a1 += __shfl_xor(a1, 1);
          if ((c.lane & 7) == 0) gates[(size_t)row * 8 + gsel] = a1 + gbias; }
    }
}
__device__ __forceinline__ void phase8(PP P, const Ctx& c, bf16_t* H) {
    const float* mod = (const float*)(P->ws + WS_MOD); const bf16_t* XP = (const bf16_t*)(P->ws + WS_XP); bf16_t* X1 = (bf16_t*)(P->ws + WS_X1);
    f32x4 g1v[4], b1v[4];
#pragma unroll
    for (int j = 0; j < 4; ++j) { g1v[j] = *(const f32x4*)(P->ln1g + 4 * c.lane + 256 * j); b1v[j] = *(const f32x4*)(P->ln1b + 4 * c.lane + 256 * j); }
    u32x2 nv[4];
    if (c.vw < MT) {
#pragma unroll
        for (int j = 0; j < 4; ++j) nv[j] = *(const u32x2*)(XP + (size_t)c.vw * D + 4 * c.lane + 256 * j); }
    int cseq = -1; f32x4 shr[4], scr1[4];
    for (int row = c.vw; row < MT; row += c.nvw) {
        { const int sq = seq_of_row(row); if (sq != cseq) { cseq = sq; const float* mr = mod + (size_t)sq * 6144;
#pragma unroll
            for (int j = 0; j < 4; ++j) { shr[j] = *(const f32x4*)(mr + 3072 + 4 * c.lane + 256 * j); scr1[j] = *(const f32x4*)(mr + 4096 + 4 * c.lane + 256 * j) + 1.f; } } }
        f32x4 v[4];
#pragma unroll
        for (int j = 0; j < 4; ++j) v[j] = (f32x4){lo16(nv[j].x), hi16(nv[j].x), lo16(nv[j].y), hi16(nv[j].y)};
        { const int nr = row + c.nvw; if (nr < MT) {
#pragma unroll
            for (int j = 0; j < 4; ++j) nv[j] = *(const u32x2*)(XP + (size_t)nr * D + 4 * c.lane + 256 * j); } }
        float mean, rstd; ln_stats(v, mean, rstd);
#pragma unroll
        for (int j = 0; j < 4; ++j) { v[j] = (v[j] - mean) * rstd * g1v[j] + b1v[j];
            u32x2 w; w.x = pk2(v[j][0], v[j][1]); w.y = pk2(v[j][2], v[j][3]); *(u32x2*)(X1 + (size_t)row * D + 4 * c.lane + 256 * j) = w; }
        ln_stats(v, mean, rstd);
#pragma unroll
        for (int j = 0; j < 4; ++j) { const f32x4 h = (v[j] - mean) * rstd * scr1[j] + shr[j];
            u32x2 w; w.x = pk2(h[0], h[1]); w.y = pk2(h[2], h[3]); *(u32x2*)(H + (size_t)row * D + 4 * c.lane + 256 * j) = w; }
    }
}
__device__ __forceinline__ void phase12(PP P, const Ctx& c) {
    for (int row = MP + c.vw; row < MT; row += c.nvw) {
        float* xr = P->out + (size_t)row * D;
        f32x4 v[4];
#pragma unroll
        for (int j = 0; j < 4; ++j) v[j] = *(const f32x4*)(xr + 4 * c.lane + 256 * j);
        float mean, rstd; ln_stats(v, mean, rstd);
#pragma unroll
        for (int j = 0; j < 4; ++j) { const f32x4 g = *(const f32x4*)(P->ln2g + 4 * c.lane + 256 * j), b = *(const f32x4*)(P->ln2b + 4 * c.lane + 256 * j);
            *(f32x4*)(xr + 4 * c.lane + 256 * j) = (v[j] - mean) * rstd * g + b; }
    }
}

__device__ __forceinline__ float log_sigmoid(float x) { return fminf(x, 0.f) - log1pf(__expf(-fabsf(x))); }
__device__ __forceinline__ void chunk_gates(PP P, float* sm, int row0, int h, const Ctx& c) {
    if (c.wave == 0) {
        const float* gates = (const float*)(P->ws + WS_GATES); const int l = c.lane;
        const float* g0 = gates + (size_t)(row0 + 2 * l) * 8;
        const float f0 = log_sigmoid(g0[4 + h]), f1 = log_sigmoid(g0[12 + h]), i0 = g0[h], i1 = g0[8 + h];
        float x = f0 + f1;
#pragma unroll
        for (int o = 1; o < 64; o <<= 1) { const float t = __shfl_up(x, o); if (l >= o) x += t; }
        const float b1 = x, b0 = x - f1, a0 = i0 - b0, a1 = i1 - b1;
        float m = fmaxf(a0, a1);
#pragma unroll
        for (int o = 1; o < 64; o <<= 1) { const float t = __shfl_up(m, o); if (l >= o) m = fmaxf(m, t); }
        float mp = __shfl_up(m, 1); if (l == 0) mp = -INFINITY;
        *(f32x2*)(sm + 2 * l) = (f32x2){f0, f1}; *(f32x2*)(sm + 128 + 2 * l) = (f32x2){i0, i1}; *(f32x2*)(sm + 256 + 2 * l) = (f32x2){b0, b1};
        *(f32x2*)(sm + 384 + 2 * l) = (f32x2){a0, a1}; *(f32x2*)(sm + 512 + 2 * l) = (f32x2){fmaxf(mp, a0), m};
    }
    __syncthreads();
}
constexpr int LP = 136;

__device__ __forceinline__ void mlstm_local_unit(PP P, unsigned char* lds, const Ctx& c, int unit) {
    const int bh = unit >> 6, ch = unit & 63, b = bh >> 2, h = bh & 3, row0 = b * SEQ + ch * 128;
    bf16_t* vT = (bf16_t*)lds; bf16_t* kT = (bf16_t*)(lds + 256 * LP * 2); float* sm = (float*)(lds + 384 * LP * 2); float* sw = sm + 640;
    const bf16_t* Z0 = (const bf16_t*)(P->ws + WS_Z0); const bf16_t* Z1 = (const bf16_t*)(P->ws + WS_Z1);
    u32x4 rv[8], rkk[4];
#pragma unroll
    for (int i = 0; i < 8; ++i) { const int s = (c.lane >> 1) + 32 * (i & 3), c8 = 4 * c.wave + 2 * (i >> 2) + (c.lane & 1); rv[i] = *(const u32x4*)(Z1 + (size_t)(row0 + s) * 2048 + 256 * h + 8 * c8); }
#pragma unroll
    for (int i = 0; i < 4; ++i) { const int s = (c.lane >> 1) + 32 * i, c8 = 2 * c.wave + (c.lane & 1); rkk[i] = *(const u32x4*)(Z0 + (size_t)(row0 + s) * 1024 + 512 + 128 * h + 8 * c8); }
    chunk_gates(P, sm, row0, h, c);
    const float AT = sm[512 + 127], bT = sm[256 + 127];
    if (c.tid < 128) sw[c.tid] = __expf(sm[384 + c.tid] - AT);
    if (c.tid == 0) { float* chs = (float*)(P->ws + WS_MISC + MISC_CH); chs[(bh * 64 + ch) * 2] = bT; chs[(bh * 64 + ch) * 2 + 1] = AT; }
    __syncthreads();
#pragma unroll
    for (int i = 0; i < 8; ++i) { const int s = (c.lane >> 1) + 32 * (i & 3), c8 = 4 * c.wave + 2 * (i >> 2) + (c.lane & 1); const u32x4 x = rv[i]; const float w = sw[s];
#pragma unroll
        for (int q = 0; q < 4; ++q) { vT[(8 * c8 + 2 * q) * LP + s] = (bf16_t)f2bf(lo16(x[q]) * w); vT[(8 * c8 + 2 * q + 1) * LP + s] = (bf16_t)f2bf(hi16(x[q]) * w); } }
#pragma unroll
    for (int i = 0; i < 4; ++i) { const int s = (c.lane >> 1) + 32 * i, c8 = 2 * c.wave + (c.lane & 1); const u32x4 x = rkk[i];
#pragma unroll
        for (int q = 0; q < 4; ++q) { kT[(8 * c8 + 2 * q) * LP + s] = (bf16_t)(x[q] & 0xffffu); kT[(8 * c8 + 2 * q + 1) * LP + s] = (bf16_t)(x[q] >> 16); } }
    __syncthreads();
    { const int d = c.tid & 127, part = c.tid >> 7; float s = 0.f;
#pragma unroll
      for (int i = 0; i < 4; ++i) { const u32x4 x = *(const u32x4*)(kT + d * LP + 32 * part + 8 * i);
#pragma unroll
          for (int q = 0; q < 4; ++q) s += lo16(x[q]) * sw[32 * part + 8 * i + 2 * q] + hi16(x[q]) * sw[32 * part + 8 * i + 2 * q + 1]; }
      sw[128 + c.tid] = s; }
    const int ql = c.lane & 31, hh = c.lane >> 5;
    f32x16 acc[4];
#pragma unroll
    for (int i = 0; i < 4; ++i)
#pragma unroll
        for (int r = 0; r < 16; ++r) acc[i][r] = 0.f;
#pragma unroll
    for (int ks = 0; ks < 8; ++ks) { const bf16x8 bv = *(const bf16x8*)(vT + (32 * c.wave + ql) * LP + 16 * ks + 8 * hh);
#pragma unroll
        for (int i = 0; i < 4; ++i) { const bf16x8 ak = *(const bf16x8*)(kT + (32 * i + ql) * LP + 16 * ks + 8 * hh); acc[i] = __builtin_amdgcn_mfma_f32_32x32x16_bf16(ak, bv, acc[i], 0, 0, 0); } }
    bf16_t* U = (bf16_t*)P->out + (size_t)(bh * 64 + ch) * 32768 + (size_t)(32 * c.wave + ql) * 128;
#pragma unroll
    for (int i = 0; i < 4; ++i)
#pragma unroll
        for (int g4 = 0; g4 < 4; ++g4) { u32x2 w; w.x = pk2(acc[i][4 * g4], acc[i][4 * g4 + 1]); w.y = pk2(acc[i][4 * g4 + 2], acc[i][4 * g4 + 3]); *(u32x2*)(U + 32 * i + 8 * g4 + 4 * hh) = w; }
    __syncthreads();
    if (c.tid < 128) ((float*)(P->ws + WS_MISC + MISC_UN))[(size_t)(bh * 64 + ch) * 128 + c.tid] = (sw[128 + c.tid] + sw[256 + c.tid]) + (sw[384 + c.tid] + sw[512 + c.tid]);
    __syncthreads();
}

__device__ __forceinline__ void swa_prompt_unit(PP P, unsigned char* lds, const Ctx& c, int unit) {
    const int qb = unit & 127, kvh = (unit >> 7) & 3, b = unit >> 9, q0 = qb * 64, key0 = q0 - 128;
    bf16_t* Ks = (bf16_t*)lds; bf16_t* VT = (bf16_t*)(lds + 192 * 72 * 2);
    bf16_t* Z1 = (bf16_t*)(P->ws + WS_Z1); const bf16_t* Z2 = (const bf16_t*)(P->ws + WS_Z2);
#pragma unroll
    for (int i = 0; i < 3; ++i) { const int key = (c.lane >> 1) + 32 * (2 * i + (c.wave >> 2)), c8 = 2 * (c.wave & 3) + (c.lane & 1), kpos = key0 + key;
        u32x4 kx = (u32x4){0u, 0u, 0u, 0u}, vx = kx;
        if (kpos >= 0) { const bf16_t* rp = Z2 + (size_t)(b * SEQ + kpos) * 512 + kvh * 64 + 8 * c8; kx = *(const u32x4*)rp; vx = *(const u32x4*)(rp + 256); }
        *(u32x4*)(Ks + key * 72 + 8 * c8) = kx;
#pragma unroll
        for (int q = 0; q < 4; ++q) { VT[(8 * c8 + 2 * q) * 200 + key] = (bf16_t)(vx[q] & 0xffffu); VT[(8 * c8 + 2 * q + 1) * 200 + key] = (bf16_t)(vx[q] >> 16); } }
    __syncthreads();
    const int g = c.wave & 3, half = c.wave >> 2, head = 4 * kvh + g, ql = c.lane & 31, hh = c.lane >> 5;
    const size_t qrow = (size_t)b * SEQ + q0 + 32 * half + ql;
    bf16_t* qp = Z1 + qrow * 2048 + 1024 + head * 64;
    bf16x8 qf[4];
#pragma unroll
    for (int ks = 0; ks < 4; ++ks) qf[ks] = *(const bf16x8*)(qp + 16 * ks + 8 * hh);
    f32x16 st[5];
#pragma unroll
    for (int kt = 0; kt < 5; ++kt) {
#pragma unroll
        for (int r = 0; r < 16; ++r) st[kt][r] = 0.f;
#pragma unroll
        for (int ks = 0; ks < 4; ++ks) { const bf16x8 a = *(const bf16x8*)(Ks + (32 * half + 32 * kt + ql) * 72 + 16 * ks + 8 * hh); st[kt] = __builtin_amdgcn_mfma_f32_32x32x16_bf16(a, qf[ks], st[kt], 0, 0, 0); } }
    const float slope = exp2f(-0.5f * (float)(head + 1)), sink = P->sinks[head];
    float mx = sink;
    {
        const float nsl = -slope, bf = (float)(ql - 4 * hh); const int qh = ql - 4 * hh, kp0 = q0 + 32 * half - 128 + 4 * hh; const bool edge = q0 < 128;
#pragma unroll
        for (int kt = 0; kt < 5; ++kt)
#pragma unroll
            for (int r = 0; r < 16; ++r) { const int kc = (r & 3) + 8 * (r >> 2);
                float s = nsl * (bf + (float)(128 - 32 * kt - kc)) + st[kt][r];
                if (kt == 0) s = (kc > qh) ? s : -INFINITY;
                if (kt == 4) s = (kc <= qh) ? s : -INFINITY;
                if (edge && kt < 4) s = (kp0 + 32 * kt + kc >= 0) ? s : -INFINITY;
                st[kt][r] = s; mx = fmaxf(mx, s); } }
    mx = fmaxf(mx, __shfl_xor(mx, 32));
    float sum = 0.f;
#pragma unroll
    for (int kt = 0; kt < 5; ++kt)
#pragma unroll
        for (int r = 0; r < 16; ++r) { const float p = __expf(st[kt][r] - mx); st[kt][r] = p; sum += p; }
    sum += __shfl_xor(sum, 32);
    const float inv = 1.f / (sum + __expf(sink - mx));
    f32x16 ot[2];
#pragma unroll
    for (int db = 0; db < 2; ++db)
#pragma unroll
        for (int r = 0; r < 16; ++r) ot[db][r] = 0.f;
#pragma unroll
    for (int kt = 0; kt < 5; ++kt)
#pragma unroll
        for (int a2 = 0; a2 < 2; ++a2) { bf16x8 pb;
#pragma unroll
            for (int j = 0; j < 8; ++j) pb[j] = (short)f2bf(st[kt][8 * a2 + j]);
#pragma unroll
            for (int db = 0; db < 2; ++db) { const bf16_t* vp = VT + (32 * db + ql) * 200 + 32 * half + 32 * kt + 16 * a2 + 4 * hh;
                const u32x2 v0 = *(const u32x2*)vp, v1 = *(const u32x2*)(vp + 8); u32x4 vv; vv.x = v0.x; vv.y = v0.y; vv.z = v1.x; vv.w = v1.y;
                ot[db] = __builtin_amdgcn_mfma_f32_32x32x16_bf16(__builtin_bit_cast(bf16x8, vv), pb, ot[db], 0, 0, 0); } }
#pragma unroll
    for (int db = 0; db < 2; ++db)
#pragma unroll
        for (int g4 = 0; g4 < 4; ++g4) { const int d = 32 * db + 8 * g4 + 4 * hh; u32x2 w; w.x = pk2(ot[db][4 * g4] * inv, ot[db][4 * g4 + 1] * inv); w.y = pk2(ot[db][4 * g4 + 2] * inv, ot[db][4 * g4 + 3] * inv);
            *(u32x2*)(qp + d) = w; }
    __syncthreads();
}

__device__ __forceinline__ void mlstm_sample_unit(PP P, unsigned char* lds, const Ctx& c, int unit) {
    const int b = unit >> 2, h = unit & 3, row0 = MP + 4 * b, tid = c.tid;
    float* sq = (float*)lds; float* sk = sq + 512; float* sv = sk + 512; float* sqk = sv + 1024; float* snq = sqk + 16; float* shv = snq + 4;
    const float* gates = (const float*)(P->ws + WS_GATES); const bf16_t* Z0 = (const bf16_t*)(P->ws + WS_Z0); bf16_t* Z1 = (bf16_t*)(P->ws + WS_Z1); const bf16_t* Z3 = (const bf16_t*)(P->ws + WS_Z3);
    const int chunk = tid & 31, rbase = tid >> 5; const size_t cbase = (size_t)(b * 4 + h) * 32768 + 4 * chunk;
    f32x4 cA[8];
#pragma unroll
    for (int j = 0; j < 8; ++j) cA[j] = *(const f32x4*)(P->st_C + cbase + (size_t)(rbase + 16 * j) * 128);
    float ig[4], bb[4], aa[4], AA[4], Mt[4], ain[4], einv[4], wsv[4];
    { float run = 0.f, mxa = -INFINITY;
#pragma unroll
      for (int t = 0; t < 4; ++t) { ig[t] = gates[(size_t)(row0 + t) * 8 + h]; run += log_sigmoid(gates[(size_t)(row0 + t) * 8 + 4 + h]); bb[t] = run; aa[t] = ig[t] - run; mxa = fmaxf(mxa, aa[t]); AA[t] = mxa; } }
    const float m0 = P->st_m[b * 4 + h];
#pragma unroll
    for (int t = 0; t < 4; ++t) { Mt[t] = fmaxf(m0, AA[t]); ain[t] = __expf(m0 - Mt[t]); einv[t] = __expf(-(bb[t] + Mt[t])); }
    const float MTl = Mt[3], decay = __expf(m0 - MTl), m_new = bb[3] + MTl;
#pragma unroll
    for (int s = 0; s < 4; ++s) wsv[s] = __expf(aa[s] - MTl);
    { const int t = tid >> 7, d = tid & 127; sq[tid] = bf2f(Z0[(size_t)(row0 + t) * 1024 + 128 * h + d]); sk[tid] = bf2f(Z0[(size_t)(row0 + t) * 1024 + 512 + 128 * h + d]);
#pragma unroll
      for (int i = 0; i < 2; ++i) { const int id = tid + 512 * i, tt = id >> 8, vc = id & 255; sv[id] = bf2f(Z1[(size_t)(row0 + tt) * 2048 + 256 * h + vc]); } }
    __syncthreads();
    { const float* n0 = P->st_n + (size_t)(b * 4 + h) * 128;
#pragma unroll
      for (int k = 0; k < 3; ++k) { const int i = c.wave + 8 * k;
          if (i < 20) { float p;
              if (i < 16) { const int t = i >> 2, s = i & 3; p = sq[t * 128 + c.lane] * sk[s * 128 + c.lane] + sq[t * 128 + 64 + c.lane] * sk[s * 128 + 64 + c.lane]; }
              else { const int t = i - 16; p = n0[c.lane] * sq[t * 128 + c.lane] + n0[64 + c.lane] * sq[t * 128 + 64 + c.lane]; }
              p = wave_sum(p); if (c.lane == 0) { if (i < 16) sqk[i] = p; else snq[i - 16] = p; } } } }
    __syncthreads();
    float smat[4][4], dinv[4];
#pragma unroll
    for (int t = 0; t < 4; ++t) { float den = 0.f;
#pragma unroll
        for (int s = 0; s < 4; ++s) { smat[t][s] = (s <= t) ? sqk[t * 4 + s] * __expf(aa[s] - Mt[t]) : 0.f; den += smat[t][s]; }
        den += ain[t] * snq[t]; dinv[t] = 1.f / fmaxf(fabsf(den), einv[t]); }
    {
      f32x4 cB[8];
#pragma unroll
      for (int j = 0; j < 8; ++j) cB[j] = *(const f32x4*)(P->st_C + cbase + (size_t)(rbase + 16 * (j + 8)) * 128);
      f32x4 q4[4], k4[4];
#pragma unroll
      for (int t = 0; t < 4; ++t) { q4[t] = *(const f32x4*)(sq + t * 128 + 4 * chunk); k4[t] = *(const f32x4*)(sk + t * 128 + 4 * chunk); }
#pragma unroll
      for (int j = 0; j < 16; ++j) { const int row = rbase + 16 * j;
          const f32x4 c4 = j < 8 ? cA[j & 7] : cB[j & 7];
          float p[4]; f32x4 nw = c4 * decay;
#pragma unroll
          for (int t = 0; t < 4; ++t) { p[t] = (c4[0] * q4[t][0] + c4[1] * q4[t][1]) + (c4[2] * q4[t][2] + c4[3] * q4[t][3]); nw = nw + k4[t] * (wsv[t] * sv[t * 256 + row]); }
          *(f32x4*)(P->out + O_SC + cbase + (size_t)row * 128) = nw;
#pragma unroll
          for (int o = 1; o < 32; o <<= 1) {
#pragma unroll
              for (int t = 0; t < 4; ++t) p[t] += __shfl_xor(p[t], o); }
          if (chunk == 0) {
#pragma unroll
              for (int t = 0; t < 4; ++t) { float num = ain[t] * p[t];
#pragma unroll
                  for (int s = 0; s < 4; ++s) num += smat[t][s] * sv[s * 256 + row];
                  shv[t * 256 + row] = num * dinv[t]; } } } }
    if (tid < 128) { const float* n0 = P->st_n + (size_t)(b * 4 + h) * 128; float a = decay * n0[tid];
#pragma unroll
        for (int s = 0; s < 4; ++s) a += wsv[s] * sk[s * 128 + tid];
        P->out[O_SN + (size_t)(b * 4 + h) * 128 + tid] = a; }
    if (tid == 0) P->out[O_SM + b * 4 + h] = m_new;
    __syncthreads();
    if (c.wave < 4) { const int t = c.wave; float x[4], s = 0.f;
#pragma unroll
        for (int i = 0; i < 4; ++i) { x[i] = shv[t * 256 + c.lane + 64 * i]; s += x[i]; }
        const float mean = wave_sum(s) * (1.f / 256.f); float q = 0.f;
#pragma unroll
        for (int i = 0; i < 4; ++i) { x[i] -= mean; q += x[i] * x[i]; }
        const float rstd = 1.f / sqrtf(wave_sum(q) * (1.f / 256.f) + LN_EPS);
#pragma unroll
        for (int i = 0; i < 4; ++i) { const int vc = 256 * h + c.lane + 64 * i; const float og = bf2f(Z3[(size_t)(row0 + t) * 1024 + vc]);
            Z1[(size_t)(row0 + t) * 2048 + vc] = (bf16_t)f2bf(x[i] * rstd * P->mnorm[vc] * og); } }
    __syncthreads();
}

__device__ __forceinline__ void swa_sample_unit(PP P, unsigned char* lds, const Ctx& c, int unit) {
    const int b = unit >> 2, kvh = unit & 3, row0 = MP + 4 * b, tid = c.tid;
    constexpr int KP = 68;
    float* sK = (float*)lds; float* sV = sK + 132 * KP; float* sQ = sV + 132 * KP; float* sP = sQ + 1024;
    bf16_t* Z1 = (bf16_t*)(P->ws + WS_Z1); const bf16_t* Z2 = (const bf16_t*)(P->ws + WS_Z2);
    { f32x4 kx[4], vx[4];
#pragma unroll
      for (int i = 0; i < 4; ++i) { const int j = tid + 512 * i, idx = j >> 4, d4 = j & 15; const size_t o = ((size_t)(b * 128 + idx) * 4 + kvh) * 64 + 4 * d4; kx[i] = *(const f32x4*)(P->ck + o); vx[i] = *(const f32x4*)(P->cv + o); }
#pragma unroll
      for (int i = 0; i < 4; ++i) { const int j = tid + 512 * i, idx = j >> 4, d4 = j & 15;
          *(f32x4*)(sK + idx * KP + 4 * d4) = kx[i]; *(f32x4*)(sV + idx * KP + 4 * d4) = vx[i];
          if (idx >= 4) { const size_t o = ((size_t)(b * 128 + idx - 4) * 4 + kvh) * 64 + 4 * d4; *(f32x4*)(P->out + O_SK + o) = kx[i]; *(f32x4*)(P->out + O_SV + o) = vx[i]; } }
      if (tid < 256) { const int r = tid >> 6, d = tid & 63; const bf16_t* rp = Z2 + (size_t)(row0 + r) * 512 + kvh * 64 + d; const float kv = bf2f(rp[0]), vv = bf2f(rp[256]);
          sK[(128 + r) * KP + d] = kv; sV[(128 + r) * KP + d] = vv; const size_t o = ((size_t)(b * 128 + 124 + r) * 4 + kvh) * 64 + d; P->out[O_SK + o] = kv; P->out[O_SV + o] = vv; } }
#pragma unroll
    for (int i = 0; i < 2; ++i) { const int id = tid + 512 * i, pair = id >> 6, d = id & 63, t = pair >> 2, g = pair & 3; sQ[id] = bf2f(Z1[(size_t)(row0 + t) * 2048 + 1024 + (4 * kvh + g) * 64 + d]); }
    __syncthreads();
    for (int id = tid; id < 16 * 132; id += 512) { const int pair = id / 132, idx = id % 132, t = pair >> 2, g = pair & 3, delta = 128 + t - idx;
        float s = -INFINITY;
        if (delta >= 0 && delta < 128) { float a = 0.f;
#pragma unroll
            for (int cc = 0; cc < 16; ++cc) { const f32x4 q = *(const f32x4*)(sQ + pair * 64 + 4 * cc), k = *(const f32x4*)(sK + idx * KP + 4 * cc); a += (q[0] * k[0] + q[1] * k[1]) + (q[2] * k[2] + q[3] * k[3]); }
            s = a - exp2f(-0.5f * (float)(4 * kvh + g + 1)) * (float)delta; }
        sP[id] = s; }
    __syncthreads();
#pragma unroll
    for (int pp = 0; pp < 2; ++pp) { const int pair = 2 * c.wave + pp, g = pair & 3; const float sink = P->sinks[4 * kvh + g];
        float x[3], mx = sink;
#pragma unroll
        for (int i = 0; i < 3; ++i) { const int idx = c.lane + 64 * i; x[i] = idx < 132 ? sP[pair * 132 + idx] : -INFINITY; mx = fmaxf(mx, x[i]); }
        mx = wave_max(mx); float sum = 0.f;
#pragma unroll
        for (int i = 0; i < 3; ++i) { x[i] = __expf(x[i] - mx); sum += x[i]; }
        const float inv = 1.f / (wave_sum(sum) + __expf(sink - mx));
#pragma unroll
        for (int i = 0; i < 3; ++i) { const int idx = c.lane + 64 * i; if (idx < 132) sP[pair * 132 + idx] = x[i] * inv; } }
    __syncthreads();
    {
        const int pair = tid >> 5, hf = (tid >> 4) & 1, d4 = tid & 15, t = pair >> 2, g = pair & 3;
        f32x4 o = (f32x4){0.f, 0.f, 0.f, 0.f};
#pragma unroll 6
        for (int i = 0; i < 66; ++i) { const int idx = 66 * hf + i; o = o + *(const f32x4*)(sV + idx * KP + 4 * d4) * sP[pair * 132 + idx]; }
#pragma unroll
        for (int e = 0; e < 4; ++e) o[e] += __shfl_xor(o[e], 16);
        if (hf == 0) { u32x2 w; w.x = pk2(o[0], o[1]); w.y = pk2(o[2], o[3]); *(u32x2*)(Z1 + (size_t)(row0 + t) * 2048 + 1024 + (4 * kvh + g) * 64 + 4 * d4) = w; } }
    __syncthreads();
}

__device__ __forceinline__ void phase3(PP P, unsigned char* lds, const Ctx& c) {
    { const bf16_t* Z2 = (const bf16_t*)(P->ws + WS_Z2);
      for (int i = blockIdx.x * 512 + c.tid; i < 2 * 128 * 512; i += gridDim.x * 512) { const int cc = i & 511, r = (i >> 9) & 127, b = i >> 16;
          const float v = bf2f(Z2[(size_t)(b * SEQ + SEQ - 128 + r) * 512 + cc]);
          if (cc < 256) P->out[O_PK + (size_t)(b * 128 + r) * 256 + cc] = v; else P->out[O_PV + (size_t)(b * 128 + r) * 256 + cc - 256] = v; } }
    if ((blockIdx.x >> 3) & 1) {
        for (int u = blockIdx.x; u < 512; u += gridDim.x) mlstm_sample_unit(P, lds, c, u);
        for (int u = blockIdx.x; u < 512; u += gridDim.x) swa_sample_unit(P, lds, c, u);
        for (int u = blockIdx.x; u < 512; u += gridDim.x) mlstm_local_unit(P, lds, c, u);
        for (int u = blockIdx.x; u < 1024; u += gridDim.x) swa_prompt_unit(P, lds, c, u);
    } else {
        for (int u = blockIdx.x; u < 512; u += gridDim.x) mlstm_local_unit(P, lds, c, u);
        for (int u = blockIdx.x; u < 1024; u += gridDim.x) swa_prompt_unit(P, lds, c, u);
        for (int u = blockIdx.x; u < 512; u += gridDim.x) mlstm_sample_unit(P, lds, c, u);
        for (int u = blockIdx.x; u < 512; u += gridDim.x) swa_sample_unit(P, lds, c, u);
    }
}

__device__ __forceinline__ void phase4(PP P, unsigned char* lds, const Ctx& c) {
    float* sal = (float*)lds; float* sbe = sal + 64;
    const float* chs = (const float*)(P->ws + WS_MISC + MISC_CH); float* mc = (float*)(P->ws + WS_MISC + MISC_MC); float* un = (float*)(P->ws + WS_MISC + MISC_UN);
    for (int vb = blockIdx.x; vb < 256; vb += gridDim.x) {
        const int bh = vb >> 5, part = vb & 31;
        __syncthreads();
        if (c.tid < 128) sbe[64 + c.tid] = chs[bh * 128 + c.tid];
        __syncthreads();
        if (c.tid == 0) { float m = 0.f;
            for (int ch = 0; ch < 64; ++ch) { sbe[192 + ch] = m; m = sbe[64 + 2 * ch] + fmaxf(m, sbe[65 + 2 * ch]); }
            sbe[256] = m; }
        __syncthreads();
        if (c.tid < 64) { const float m = sbe[192 + c.tid], AT = sbe[65 + 2 * c.tid], Mc = fmaxf(m, AT); sal[c.tid] = __expf(m - Mc); sbe[c.tid] = __expf(AT - Mc); if (part == 0) mc[bh * 65 + c.tid] = m; }
        if (c.tid == 64 && part == 0) { const float m = sbe[256]; mc[bh * 65 + 64] = m; P->out[O_PM + bh] = m; }
        __syncthreads();
        { const int e = part * 1024 + 2 * c.tid; unsigned* U = (unsigned*)((bf16_t*)P->out + (size_t)bh * 64 * 32768 + e); f32x2 C = (f32x2){0.f, 0.f};
#pragma unroll 16
          for (int ch = 0; ch < 64; ++ch) { unsigned* p = U + (size_t)ch * 16384; const unsigned u = *p; *p = pk2(C[0], C[1]); C[0] = C[0] * sal[ch] + lo16(u) * sbe[ch]; C[1] = C[1] * sal[ch] + hi16(u) * sbe[ch]; }
          *(f32x2*)(P->out + O_PC + (size_t)bh * 32768 + e) = C; }
        if (part == 0 && c.tid < 128) { float n = 0.f; float uu[64];
#pragma unroll
            for (int ch = 0; ch < 64; ++ch) uu[ch] = un[(size_t)(bh * 64 + ch) * 128 + c.tid];
#pragma unroll
            for (int ch = 0; ch < 64; ++ch) { un[(size_t)(bh * 64 + ch) * 128 + c.tid] = n; n = n * sal[ch] + uu[ch] * sbe[ch]; }
            P->out[O_PN + bh * 128 + c.tid] = n; }
    }
}

__device__ __forceinline__ void mlstm_out_unit(PP P, unsigned char* lds, const Ctx& c, int unit) {
    const int bh = unit >> 6, ch = unit & 63, b = bh >> 2, h = bh & 3, row0 = b * SEQ + ch * 128, tid = c.tid;
    bf16_t* Ql = (bf16_t*)lds; bf16_t* Kl = (bf16_t*)(lds + 128 * LP * 2); bf16_t* Cl = (bf16_t*)(lds + 256 * LP * 2);
    float* sm = (float*)(lds + 512 * LP * 2);
    float* sMt = sm + 640; float* sain = sMt + 128; float* seinv = sain + 128; float* sdinv = seinv + 128; float* sn = sdinv + 128; float* spart = sn + 128;
    const bf16_t* Z0 = (const bf16_t*)(P->ws + WS_Z0); bf16_t* Z1 = (bf16_t*)(P->ws + WS_Z1); const bf16_t* Z3 = (const bf16_t*)(P->ws + WS_Z3);
    u32x4 rq[4], rk[4], rc[8];
#pragma unroll
    for (int i = 0; i < 4; ++i) { const int id = tid + 512 * i, t = id >> 4, c8 = id & 15; const bf16_t* rp = Z0 + (size_t)(row0 + t) * 1024 + 128 * h + 8 * c8; rq[i] = *(const u32x4*)rp; rk[i] = *(const u32x4*)(rp + 512); }
    { const bf16_t* Cs = (const bf16_t*)P->out + (size_t)(bh * 64 + ch) * 32768;
#pragma unroll
      for (int i = 0; i < 8; ++i) { const int id = tid + 512 * i, v = id >> 4, c8 = id & 15; rc[i] = *(const u32x4*)(Cs + v * 128 + 8 * c8); } }
    chunk_gates(P, sm, row0, h, c);
    const float mcv = ((const float*)(P->ws + WS_MISC + MISC_MC))[bh * 65 + ch];
    if (tid < 128) { const float Mt = fmaxf(mcv, sm[512 + tid]); sMt[tid] = Mt; sain[tid] = __expf(mcv - Mt); seinv[tid] = __expf(-(sm[256 + tid] + Mt));
        sn[tid] = ((const float*)(P->ws + WS_MISC + MISC_UN))[(size_t)(bh * 64 + ch) * 128 + tid]; }
#pragma unroll
    for (int i = 0; i < 4; ++i) { const int id = tid + 512 * i, t = id >> 4, c8 = id & 15; *(u32x4*)(Ql + t * LP + 8 * c8) = rq[i]; *(u32x4*)(Kl + t * LP + 8 * c8) = rk[i]; }
#pragma unroll
    for (int i = 0; i < 8; ++i) { const int id = tid + 512 * i, v = id >> 4, c8 = id & 15; *(u32x4*)(Cl + v * LP + 8 * c8) = rc[i]; }
    __syncthreads();
    const int ql = c.lane & 31, hh = c.lane >> 5;
    { const int sb = c.wave & 3, th = c.wave >> 2;
      f32x16 sacc[2];
#pragma unroll
      for (int j = 0; j < 2; ++j) {
#pragma unroll
          for (int r = 0; r < 16; ++r) sacc[j][r] = 0.f;
          const int tt = 2 * th + j;
          if (tt >= sb) {
#pragma unroll
              for (int ks = 0; ks < 8; ++ks) { const bf16x8 a = *(const bf16x8*)(Kl + (32 * sb + ql) * LP + 16 * ks + 8 * hh), bq = *(const bf16x8*)(Ql + (32 * tt + ql) * LP + 16 * ks + 8 * hh);
                  sacc[j] = __builtin_amdgcn_mfma_f32_32x32x16_bf16(a, bq, sacc[j], 0, 0, 0); } } }
      __syncthreads();
#pragma unroll
      for (int j = 0; j < 2; ++j) { const int t = 32 * (2 * th + j) + ql; const float Mt = sMt[t];
#pragma unroll
          for (int g4 = 0; g4 < 4; ++g4) { float v[4];
#pragma unroll
              for (int e = 0; e < 4; ++e) { const int s = 32 * sb + 8 * g4 + 4 * hh + e; v[e] = (s <= t) ? sacc[j][4 * g4 + e] * __expf(sm[384 + s] - Mt) : 0.f; }
              u32x2 w; w.x = pk2(v[0], v[1]); w.y = pk2(v[2], v[3]); *(u32x2*)(Kl + t * LP + 32 * sb + 8 * g4 + 4 * hh) = w; } } }
    __syncthreads();
    { const int t = tid >> 2, part = tid & 3; float ss = 0.f, nq = 0.f;
      for (int i = 0; i < 32; ++i) { ss += bf2f(Kl[t * LP + 32 * part + i]); nq += bf2f(Ql[t * LP + 32 * part + i]) * sn[32 * part + i]; }
      ss += __shfl_xor(ss, 1); ss += __shfl_xor(ss, 2); nq += __shfl_xor(nq, 1); nq += __shfl_xor(nq, 2);
      if (part == 0) sdinv[t] = 1.f / fmaxf(fabsf(ss + sain[t] * nq), seinv[t]); }
    const int tb = c.wave & 3, vh = c.wave >> 2;
    f32x16 acc[4];
#pragma unroll
    for (int i = 0; i < 4; ++i)
#pragma unroll
        for (int r = 0; r < 16; ++r) acc[i][r] = 0.f;
#pragma unroll
    for (int ks = 0; ks < 8; ++ks) { const bf16x8 bq = *(const bf16x8*)(Ql + (32 * tb + ql) * LP + 16 * ks + 8 * hh);
#pragma unroll
        for (int i = 0; i < 4; ++i) { const bf16x8 a = *(const bf16x8*)(Cl + (32 * (4 * vh + i) + ql) * LP + 16 * ks + 8 * hh); acc[i] = __builtin_amdgcn_mfma_f32_32x32x16_bf16(a, bq, acc[i], 0, 0, 0); } }
    { const float ai = sain[32 * tb + ql];
#pragma unroll
      for (int i = 0; i < 4; ++i) acc[i] = acc[i] * ai; }
    __syncthreads();
#pragma unroll
    for (int i = 0; i < 8; ++i) { const int s = (c.lane >> 1) + 32 * (i & 3), c8 = 4 * c.wave + 2 * (i >> 2) + (c.lane & 1); const u32x4 x = *(const u32x4*)(Z1 + (size_t)(row0 + s) * 2048 + 256 * h + 8 * c8);
#pragma unroll
        for (int q = 0; q < 4; ++q) { Cl[(8 * c8 + 2 * q) * LP + s] = (bf16_t)(x[q] & 0xffffu); Cl[(8 * c8 + 2 * q + 1) * LP + s] = (bf16_t)(x[q] >> 16); } }
    __syncthreads();
    for (int ks = 0; ks < 2 * (tb + 1); ++ks) { const bf16x8 bs = *(const bf16x8*)(Kl + (32 * tb + ql) * LP + 16 * ks + 8 * hh);
#pragma unroll
        for (int i = 0; i < 4; ++i) { const bf16x8 a = *(const bf16x8*)(Cl + (32 * (4 * vh + i) + ql) * LP + 16 * ks + 8 * hh); acc[i] = __builtin_amdgcn_mfma_f32_32x32x16_bf16(a, bs, acc[i], 0, 0, 0); } }
    const int t = 32 * tb + ql; const float dinv = sdinv[t];
    float s1 = 0.f, s2 = 0.f;
#pragma unroll
    for (int i = 0; i < 4; ++i)
#pragma unroll
        for (int r = 0; r < 16; ++r) { const float x = acc[i][r] * dinv; acc[i][r] = x; s1 += x; s2 += x * x; }
    s1 += __shfl_xor(s1, 32); s2 += __shfl_xor(s2, 32);
    if (hh == 0) { spart[(vh * 128 + t) * 2] = s1; spart[(vh * 128 + t) * 2 + 1] = s2; }
    __syncthreads();
    const float mean = (spart[t * 2] + spart[(128 + t) * 2]) * (1.f / 256.f), ex2 = (spart[t * 2 + 1] + spart[(128 + t) * 2 + 1]) * (1.f / 256.f);
    const float rstd = 1.f / sqrtf(fmaxf(ex2 - mean * mean, 0.f) + LN_EPS);
    bf16_t* Tl = (bf16_t*)lds; constexpr int TP = 264;
#pragma unroll
    for (int i = 0; i < 4; ++i)
#pragma unroll
        for (int g4 = 0; g4 < 4; ++g4) { const int v0 = 32 * (4 * vh + i) + 8 * g4 + 4 * hh; u32x2 w;
            w.x = pk2((acc[i][4 * g4] - mean) * rstd, (acc[i][4 * g4 + 1] - mean) * rstd); w.y = pk2((acc[i][4 * g4 + 2] - mean) * rstd, (acc[i][4 * g4 + 3] - mean) * rstd);
            *(u32x2*)(Tl + t * TP + v0) = w; }
    __syncthreads();
#pragma unroll
    for (int k = 0; k < 8; ++k) { const int id = tid + 512 * k, t2 = id >> 5, ch = id & 31, vc = 256 * h + 8 * ch;
        const u32x4 x = *(const u32x4*)(Tl + t2 * TP + 8 * ch), og = *(const u32x4*)(Z3 + (size_t)(row0 + t2) * 1024 + vc);
        const f32x4 n0 = *(const f32x4*)(P->mnorm + vc), n1 = *(const f32x4*)(P->mnorm + vc + 4);
        u32x4 w;
        w.x = pk2(lo16(x.x) * n0[0] * lo16(og.x), hi16(x.x) * n0[1] * hi16(og.x));
        w.y = pk2(lo16(x.y) * n0[2] * lo16(og.y), hi16(x.y) * n0[3] * hi16(og.y));
        w.z = pk2(lo16(x.z) * n1[0] * lo16(og.z), hi16(x.z) * n1[1] * hi16(og.z));
        w.w = pk2(lo16(x.w) * n1[2] * lo16(og.w), hi16(x.w) * n1[3] * hi16(og.w));
        *(u32x4*)(Z1 + (size_t)(row0 + t2) * 2048 + vc) = w; }
    __syncthreads();
}

template <int NH>
__device__ __forceinline__ void small_gemm_tile(const bf16_t* A, int lda, const bf16_t* Bt, int ldb, int KH, int row0, int col0, unsigned char* lds, const Ctx& c, float (&res)[NH][4]) {
    const int ql = c.lane & 31, hh = c.lane >> 5, kw = KH >> 3, nks = kw >> 4;
    float* red = (float*)lds;
    f32x16 acc[NH][2];
#pragma unroll
    for (int h = 0; h < NH; ++h)
#pragma unroll
        for (int ct = 0; ct < 2; ++ct)
#pragma unroll
            for (int r = 0; r < 16; ++r) acc[h][ct][r] = 0.f;
    const bf16_t* ap = A + (size_t)(row0 + ql) * lda + c.wave * kw + 8 * hh;
    const bf16_t* bp0 = Bt + (size_t)(col0 + ql) * ldb + c.wave * kw + 8 * hh;
    const bf16_t* bp1 = bp0 + (size_t)32 * ldb;
#pragma unroll
    for (int h = 0; h < NH; ++h) {
#pragma unroll 4
        for (int ks = 0; ks < nks; ++ks) { const int k = h * KH + 16 * ks;
            const bf16x8 a = *(const bf16x8*)(ap + k), b0 = *(const bf16x8*)(bp0 + k), b1 = *(const bf16x8*)(bp1 + k);
            acc[h][0] = __builtin_amdgcn_mfma_f32_32x32x16_bf16(a, b0, acc[h][0], 0, 0, 0);
            acc[h][1] = __builtin_amdgcn_mfma_f32_32x32x16_bf16(a, b1, acc[h][1], 0, 0, 0); } }
#pragma unroll
    for (int h = 0; h < NH; ++h)
#pragma unroll
        for (int ct = 0; ct < 2; ++ct)
#pragma unroll
            for (int r = 0; r < 16; ++r) red[(((h * 8 + c.wave) * 2 + ct) * 16 + r) * 64 + c.lane] = acc[h][ct][r];
    __syncthreads();
#pragma unroll
    for (int h = 0; h < NH; ++h)
#pragma unroll
        for (int j = 0; j < 4; ++j) { const int e = c.tid + 512 * j, row = e >> 6, col = e & 63, ct = col >> 5, l2 = (col & 31) + 32 * ((row >> 2) & 1), r = (row & 3) + 4 * (row >> 3);
            float s = 0.f;
#pragma unroll
            for (int w = 0; w < 8; ++w) s += red[(((h * 8 + w) * 2 + ct) * 16 + r) * 64 + l2];
            res[h][j] = s; }
    __syncthreads();
}
__device__ __forceinline__ void tail_branch(PP P, unsigned char* lds, const Ctx& c) {
    const bf16_t* Z1 = (const bf16_t*)(P->ws + WS_Z1); const bf16_t* Z4 = (const bf16_t*)(P->ws + WS_Z4); bf16_t* O = (bf16_t*)(P->ws + WS_Z0);
    for (int t = blockIdx.x; t < 256; t += gridDim.x) { const int row0 = MP + (t >> 4) * 32, col0 = (t & 15) * 64;
        float res[2][4]; bf16_t gmr[4], gar[4];
#pragma unroll
        for (int j = 0; j < 4; ++j) { const int e = c.tid + 512 * j, row = row0 + (e >> 6), col = col0 + (e & 63); gmr[j] = Z4[(size_t)row * 2048 + col]; gar[j] = Z4[(size_t)row * 2048 + 1024 + col]; }
        small_gemm_tile<2>(Z1, 2048, (const bf16_t*)(P->ws + WS_WBR), 2048, 1024, row0, col0, lds, c, res);
#pragma unroll
        for (int j = 0; j < 4; ++j) { const int e = c.tid + 512 * j, row = row0 + (e >> 6), col = col0 + (e & 63);
            O[(size_t)row * 1024 + col] = (bf16_t)f2bf(bf2f(gmr[j]) * res[0][j] + bf2f(gar[j]) * res[1][j]); } }
}
__device__ __forceinline__ void tail_res(PP P, unsigned char* lds, const Ctx& c, const bf16_t* A, int lda, const bf16_t* Bt, int K, int goff, const float* bias, int inplace) {
    const float* mod = (const float*)(P->ws + WS_MOD);
    for (int t = blockIdx.x; t < 256; t += gridDim.x) { const int row0 = MP + (t >> 4) * 32, col0 = (t & 15) * 64;
        float res[1][4]; float gq[4], bq[4], xq[4];
#pragma unroll
        for (int j = 0; j < 4; ++j) { const int e = c.tid + 512 * j, row = row0 + (e >> 6), col = col0 + (e & 63);
            gq[j] = mod[(size_t)seq_of_row(row) * 6144 + goff + col]; bq[j] = bias ? bias[col] : 0.f;
            xq[j] = inplace ? bf2f(((const bf16_t*)(P->ws + WS_X1))[(size_t)row * 1024 + col]) : P->x_s[(size_t)(row - MP) * 1024 + col]; }
        small_gemm_tile<1>(A, lda, Bt, K, K, row0, col0, lds, c, res);
#pragma unroll
        for (int j = 0; j < 4; ++j) { const int e = c.tid + 512 * j, row = row0 + (e >> 6), col = col0 + (e & 63);
            const float o = ALPHA * xq[j] + gq[j] * (res[0][j] + bq[j]);
            if (inplace) P->out[(size_t)row * 1024 + col] = o; else ((bf16_t*)(P->ws + WS_XP))[(size_t)row * 1024 + col] = (bf16_t)f2bf(o); } }
}

__device__ __forceinline__ void fixup_rows(PP P, const Ctx& c, int pm) {
    const bf16_t* UB = (const bf16_t*)(P->ws + WS_UB); bf16_t* ACT = (bf16_t*)(P->ws + WS_ACT); const bool first = (pm & 31) == 0;
#pragma unroll 3
    for (int k = 0; k < 6; ++k) { const int f = c.tid + 512 * k;
        if (f < DFF) {
            float ua[4], ug[4];
#pragma unroll
            for (int s = 0; s < 4; ++s) { ua[s] = bf2f(UB[((size_t)pm * 4 + s) * F2 + f]); ug[s] = bf2f(UB[((size_t)pm * 4 + s) * F2 + DFF + f]); }
            if (first) { ua[0] = 0.f; ua[1] = 0.f; ug[0] = 0.f; ug[1] = 0.f; }
            const float cba = P->conv_b[f], cbg = P->conv_b[DFF + f];
            const float wa0 = P->conv_w[f], wa1 = P->conv_w[F2 + f], wa2 = P->conv_w[2 * F2 + f];
            const float wg0 = P->conv_w[DFF + f], wg1 = P->conv_w[F2 + DFF + f], wg2 = P->conv_w[2 * F2 + DFF + f];
#pragma unroll
            for (int rr = 0; rr < 2; ++rr) { const float av = cba + wa0 * ua[rr] + wa1 * ua[rr + 1] + wa2 * ua[rr + 2], gv = cbg + wg0 * ug[rr] + wg1 * ug[rr + 1] + wg2 * ug[rr + 2];
                ACT[(size_t)(pm * 256 + rr) * DFF + f] = (bf16_t)f2bf(gelu_tanh(av) * gv); } } }
}
__device__ __forceinline__ void pconv_out(PP P, const Ctx& c) {
    const bf16_t* UB = (const bf16_t*)(P->ws + WS_UB);
    for (int i = blockIdx.x * 512 + c.tid; i < 2 * 2 * F2; i += gridDim.x * 512) { const int col = i % F2, r = (i / F2) & 1, b = i / (2 * F2); P->out[O_PCONV + i] = bf2f(UB[((size_t)(32 * (b + 1)) * 4 + r) * F2 + col]); }
}

#define XB_TMO      128
#define XB_XCNT(j)  (256  + 64 * (j))
#define XB_XSUB(j)  (1280 + 64 * (j))
#define XB_XGEN(j)  (2304 + 64 * (j))
#define XB_TOP      3328
#define XB_TOPGEN   3392
#define XCD_BAR_WORDS 3456
#define XB_SPIN_CAP (1u << 22)
__device__ __forceinline__ unsigned xb_ld(unsigned* p)              { return __hip_atomic_load(p, __ATOMIC_RELAXED, __HIP_MEMORY_SCOPE_AGENT); }
__device__ __forceinline__ unsigned xb_add(unsigned* p, unsigned v) { return __hip_atomic_fetch_add(p, v, __ATOMIC_RELAXED, __HIP_MEMORY_SCOPE_AGENT); }
__device__ __forceinline__ unsigned xb_xcc_id() { return (unsigned)__builtin_amdgcn_s_getreg((3 << 11) | 20) & 0xFu; }
#define XB_SPIN(cond, bar) do { unsigned _sp = 0; while (cond) { __builtin_amdgcn_s_sleep(1); \
    if ((++_sp & 255u) == 0u) { if (xb_ld(&(bar)[XB_TMO])) break; if (_sp > XB_SPIN_CAP) { atomicAdd(&(bar)[XB_TMO], 1u); break; } } } } while (0)
struct XcdBarrier { unsigned* bar; unsigned x; volatile LAS unsigned* st; };
__device__ __forceinline__ XcdBarrier xcd_barrier_post(unsigned* bar, volatile LAS unsigned* st) {
    XcdBarrier b; b.bar = bar; b.x = xb_xcc_id(); b.st = st;
    if (threadIdx.x == 0) (void)xb_add(&bar[XB_XCNT(b.x)], 1u);
    return b;
}
__device__ __forceinline__ void xcd_barrier_complete(unsigned* bar, unsigned x, unsigned& nloc, unsigned& nx) {
    const unsigned G = gridDim.x * gridDim.y * gridDim.z;
    unsigned sum, cnt, mine, sp = 0u;
    for (;;) {
        sum = 0u; cnt = 0u; mine = 0u;
#pragma unroll
        for (unsigned j = 0; j < 16; ++j) { const unsigned c = xb_ld(&bar[XB_XCNT(j)]); sum += c; cnt += (c > 0u) ? 1u : 0u; mine = (j == x) ? c : mine; }
        if (sum == G) break;
        __builtin_amdgcn_s_sleep(1);
        if ((++sp & 255u) == 0u) { if (xb_ld(&bar[XB_TMO])) break; if (sp > XB_SPIN_CAP) { atomicAdd(&bar[XB_TMO], 1u); break; } }
    }
    nloc = mine > 0u ? mine : 1u; nx = cnt > 0u ? cnt : 1u;
}
__device__ __forceinline__ void xcd_barrier(const XcdBarrier& b) {
    asm volatile("s_waitcnt vmcnt(0)" ::: "memory");
    __syncthreads();
    if (threadIdx.x == 0) {
        unsigned* bar = b.bar;
        __builtin_amdgcn_s_waitcnt(0);
        unsigned nloc = b.st[0], nx = b.st[1];
        if (nloc == 0u) { xcd_barrier_complete(bar, b.x, nloc, nx); b.st[0] = nloc; b.st[1] = nx; }
        const unsigned old = xb_add(&bar[XB_XSUB(b.x)], 1u);
        const unsigned gen = old / nloc;
        if (old + 1u == (gen + 1u) * nloc) {
            __builtin_amdgcn_fence(__ATOMIC_RELEASE, "agent");
            asm volatile("s_waitcnt vmcnt(0)" ::: "memory");
            const unsigned og = xb_add(&bar[XB_TOP], 1u);
            const unsigned tg = og / nx;
            if (og + 1u == (tg + 1u) * nx) xb_add(&bar[XB_TOPGEN], 1u);
            else XB_SPIN(xb_ld(&bar[XB_TOPGEN]) == tg, bar);
            __builtin_amdgcn_fence(__ATOMIC_ACQUIRE, "agent");
            xb_add(&bar[XB_XGEN(b.x)], 1u);
            asm volatile("s_waitcnt vmcnt(0)" ::: "memory");
        } else {
            XB_SPIN(xb_ld(&bar[XB_XGEN(b.x)]) == gen, bar);
            __builtin_amdgcn_fence(__ATOMIC_ACQUIRE, "agent");
            asm volatile("s_waitcnt vmcnt(0)" ::: "memory");
        }
    }
    __syncthreads();
}

__global__ void __launch_bounds__(512, 2) fwd_megakernel(Params Pk) {
    extern __shared__ __attribute__((aligned(16))) unsigned char lds[];
    cg::grid_group grid = cg::this_grid();
    Ctx c;
#define MKCTX() do { int t_ = threadIdx.x; asm volatile("" : "+v"(t_)); c.tid = t_; c.lane = t_ & 63; c.wave = __builtin_amdgcn_readfirstlane(t_ >> 6); c.vw = c.wave * gridDim.x + blockIdx.x; c.nvw = 8 * gridDim.x; } while (0)
    MKCTX();
    LAS unsigned char* ldsl = (LAS unsigned char*)lds;
    const int G = gridDim.x, bid = blockIdx.x;
    PP P = (PP)__builtin_amdgcn_kernarg_segment_ptr();
    if (threadIdx.x < 2) ((volatile LAS unsigned*)(ldsl + LDS_BAR_OFF))[threadIdx.x] = 0u;
    __syncthreads();
    if (blockIdx.x == 0) { unsigned* zb = (unsigned*)(P->ws + WS_BAR); for (int i = threadIdx.x; i < 8192; i += 512) zb[i] = 0u; }
#define LAUNDER() asm volatile("" : "+s"(P))
#define HS ((bf16_t*)(P->out + O_SC))
#define HB ((bf16_t*)(P->ws + WS_Z0))

    if constexpr (PH_MASK & 1) phase0(P, lds, c);
    grid.sync(); LAUNDER(); MKCTX();
    XcdBarrier xbar = xcd_barrier_post((unsigned*)(P->ws + WS_BAR), (volatile LAS unsigned*)(ldsl + LDS_BAR_OFF));
    if constexpr (PH_MASK & 2) phase1(P, c, HS);
    xcd_barrier(xbar); LAUNDER(); MKCTX();
    if constexpr (PH_MASK & 4) { pg8::Gemm g{HS, (const bf16_t*)(P->ws + WS_W1T), MT, N1, 1024, 1024, 1024}; pg8::StaticOrder S; S.init(MT, N1, G, bid);
      EpiZ E{P->ws, (const float*)(P->ws + WS_MISC + MISC_BIASZ)}; pg8::gemm_phase<EpiZ>(ldsl, g, S, E);
      { const int nfull = (MT / 256) * (N1 / 256) % G; if (nfull != 0 && bid >= nfull) { MKCTX(); late_copies_a(P, lds, c, (bid - nfull) * 8 + c.wave, (G - nfull) * 8); }
        else if (nfull == 0) { MKCTX(); late_copies_a(P, lds, c, bid * 8 + c.wave, G * 8); } } }
    xcd_barrier(xbar); LAUNDER(); MKCTX();
    if constexpr (PH_MASK & 8) phase3(P, lds, c);
    xcd_barrier(xbar); LAUNDER(); MKCTX();
    if constexpr (PH_MASK & 16) phase4(P, lds, c);
    xcd_barrier(xbar); LAUNDER(); MKCTX();
    if constexpr (PH_MASK & 32) for (int u = bid; u < 512; u += G) mlstm_out_unit(P, lds, c, u);
    xcd_barrier(xbar); LAUNDER(); MKCTX();
    if constexpr (PH_MASK & 64) { pg8::Gemm g{(const bf16_t*)(P->ws + WS_Z1), (const bf16_t*)(P->ws + WS_WBR), MT, 1024, 2048, 2048, 2048}; pg8::StaticOrder S; S.init(MP, 1024, G, bid);
      EpiBranch E{(const bf16_t*)(P->ws + WS_Z4), HB}; pg8::gemm_phase<EpiBranch>(ldsl, g, S, E); MKCTX(); tail_branch(P, lds, c); }
    xcd_barrier(xbar); LAUNDER(); MKCTX();
    if constexpr (PH_MASK & 128) { pg8::Gemm g{HB, (const bf16_t*)(P->ws + WS_WOT), MT, 1024, 1024, 1024, 1024}; pg8::StaticOrder S; S.init(MP, 1024, G, bid);
      EpiRes E{P->x_p, P->x_s, (const float*)(P->ws + WS_MOD), 2048, (bf16_t*)(P->ws + WS_XP)}; pg8::gemm_phase<EpiRes>(ldsl, g, S, E); MKCTX();
      tail_res(P, lds, c, HB, 1024, (const bf16_t*)(P->ws + WS_WOT), 1024, 2048, nullptr, 0); }
    xcd_barrier(xbar); LAUNDER(); MKCTX();
    if constexpr (PH_MASK & 256) phase8(P, c, HB);
    xcd_barrier(xbar); LAUNDER(); MKCTX();
    if constexpr (PH_MASK & 512) { pg8::Gemm g{HB, (const bf16_t*)(P->ws + WS_WUT), MT, F2, 1024, 1024, 1024}; pg8::StaticOrder S; S.init(MT, F2, G, bid);
      EpiUp E{P->b_up, P->conv_w, P->conv_b, (bf16_t*)(P->ws + WS_SCR) + (size_t)bid * 65536, (bf16_t*)(P->ws + WS_UB), (bf16_t*)(P->ws + WS_US), (bf16_t*)(P->ws + WS_ACT), P->st_conv, P->out + O_SCONV};
      pg8::gemm_phase<EpiUp>(ldsl, g, S, E);
      { const int nfull = (MT / 256) * (F2 / 256) % G; if (nfull != 0 && bid >= nfull) { MKCTX(); late_copies_b(P, lds, c, (bid - nfull) * 8 + c.wave, (G - nfull) * 8); }
        else if (nfull == 0) { MKCTX(); late_copies_b(P, lds, c, bid * 8 + c.wave, G * 8); } } }
    xcd_barrier(xbar); LAUNDER(); MKCTX();
    if constexpr (PH_MASK & 2048) { pg8::Gemm g{(const bf16_t*)(P->ws + WS_ACT), (const bf16_t*)(P->ws + WS_WDT), MT, 1024, DFF, DFF, DFF}; pg8::StaticOrder S; S.init(MP, 1024, G, bid);
      { pg8::Unit u0; if (S.next(0, u0)) fixup_rows(P, c, u0.pm); asm volatile("s_waitcnt vmcnt(0)" ::: "memory"); __syncthreads(); }
      EpiDownLn E{(const float*)(P->ws + WS_MOD), P->b_down, P->ln2g, P->ln2b, P->out, (const bf16_t*)(P->ws + WS_X1), (unsigned long long*)(P->ws + WS_XBUF), (unsigned*)(P->ws + WS_CNT)}; pg8::gemm_phase<EpiDownLn>(ldsl, g, S, E); MKCTX();
      tail_res(P, lds, c, (const bf16_t*)(P->ws + WS_ACT), DFF, (const bf16_t*)(P->ws + WS_WDT), DFF, 5120, P->b_down, 1); }
    xcd_barrier(xbar); LAUNDER(); MKCTX();
    if constexpr (PH_MASK & 4096) { phase12(P, c); pconv_out(P, c); }
}
#undef LAUNDER
#undef MKCTX
#undef HS
#undef HB

extern "C" void kernel_launch(void* const* d_in, const int* in_sizes, int n_in, void* d_out, int out_size, void* d_ws, size_t ws_size, hipStream_t stream) {
    static int grid_blocks = 0;
    if (grid_blocks == 0) {
        int dev = 0, cus = 0, per_cu = 0;
        hipGetDevice(&dev);
        hipDeviceGetAttribute(&cus, hipDeviceAttributeMultiprocessorCount, dev);
        hipFuncSetAttribute((const void*)fwd_megakernel, hipFuncAttributeMaxDynamicSharedMemorySize, LDS_BYTES);
        hipOccupancyMaxActiveBlocksPerMultiprocessor(&per_cu, (const void*)fwd_megakernel, 512, LDS_BYTES);
        if (per_cu < 1) { fprintf(stderr, "occupancy query reports %d blocks/CU\n", per_cu); per_cu = 1; }
        if (per_cu > 1) per_cu = 1;
        grid_blocks = cus * per_cu;
        if (grid_blocks > 256) grid_blocks = 256;
        if (n_in != 29 || ws_size < 256 * MiB) fprintf(stderr, "kernel_launch: unexpected n_in %d / ws_size %zu\n", n_in, ws_size);
    }
    Params p{};
    const float** pp = (const float**)&p;
    for (int i = 0; i < 29; ++i) pp[i] = (const float*)d_in[i];
    p.out = (float*)d_out; p.ws = (unsigned char*)d_ws;
    void* args[] = {&p};
    hipError_t e = hipLaunchCooperativeKernel((const void*)fwd_megakernel, dim3(grid_blocks), dim3(512), args, LDS_BYTES, stream);
    if (e != hipSuccess) fprintf(stderr, "cooperative launch failed: %s (grid %d)\n", hipGetErrorString(e), grid_blocks);
}
```
